# Optimizing an MI355X kernel written in HIP

```python
import math
import jax, jax.numpy as jnp
from jax import lax
import numpy as np

D_MODEL = 1024
BATCH = 2
SEQ = 16384
DEPTH = 2
DEC_BATCH = 8
DEC_SEQ = 8192
PAST_LEN = 128

CONV_CH = 512
CONV_W = 3
RET_HEADS = 4
RET_DIM = 128
RET_WIDTH = RET_HEADS * RET_DIM
RET_CHUNK = 128
DIFF_HEADS = 8
DIFF_DIM = 64
Q_BLOCK = 128
D_FF = ((8 * D_MODEL + 3 * 256 - 1) // (3 * 256)) * 256
ROPE_THETA = 10000.0
NORM_EPS = 1e-6
GN_EPS = 1e-5
SUBLN_EPS = 1e-5
IN_PROJ_COLS = 3 * CONV_CH + 4 * RET_WIDTH
IN_SPLITS = [CONV_CH, 2 * CONV_CH, 3 * CONV_CH, 3 * CONV_CH + RET_WIDTH,
             3 * CONV_CH + 2 * RET_WIDTH, 3 * CONV_CH + 3 * RET_WIDTH]
DIFF_QK = 2 * DIFF_HEADS * DIFF_DIM
DIFF_V = DIFF_HEADS * 2 * DIFF_DIM
N_EVEN = (DEPTH + 1) // 2
N_ODD = DEPTH // 2

kernel_name = "hybrid_conv_retention_diffattn_encoder"

F32 = jnp.float32


def _rmsnorm(x, w, eps=NORM_EPS):
    xf = x.astype(F32)
    y = xf * lax.rsqrt(jnp.mean(xf * xf, axis=-1, keepdims=True) + eps)
    return y.astype(x.dtype) * w


def _rope(x):
    s, d = x.shape[-2], x.shape[-1]
    inv = ROPE_THETA ** (-jnp.arange(0, d, 2, dtype=F32) / d)
    ang = jnp.arange(s, dtype=F32)[:, None] * inv[None, :]
    cos = jnp.cos(ang).astype(x.dtype)
    sin = jnp.sin(ang).astype(x.dtype)
    x1, x2 = x[..., : d // 2], x[..., d // 2:]
    return jnp.concatenate([x1 * cos - x2 * sin, x1 * sin + x2 * cos], axis=-1)


def _retention_one_dir(q, k, v, log_gamma, strict):
    b, h, s, d = q.shape
    c = RET_CHUNK
    n = s // c
    dt = q.dtype
    qc = q.reshape(b, h, n, c, d)
    kc = k.reshape(b, h, n, c, d)
    vc = v.reshape(b, h, n, c, d)
    idx = jnp.arange(c, dtype=F32)
    rel = idx[:, None] - idx[None, :]
    mask = rel > 0 if strict else rel >= 0
    lg = log_gamma.astype(F32)
    decay_intra = jnp.where(mask[None], jnp.exp(lg[:, None, None] * jnp.maximum(rel, 0.0)[None]), 0.0).astype(dt)
    scores = jnp.einsum('bhnid,bhnjd->bhnij', qc, kc) * decay_intra[None, :, None]
    o_intra = jnp.einsum('bhnij,bhnjd->bhnid', scores, vc)
    k_decay = jnp.exp(lg[:, None] * (c - 1 - idx)[None]).astype(dt)
    kv = jnp.einsum('bhnjd,hj,bhnje->bhnde', kc, k_decay, vc)
    chunk_decay = jnp.exp(lg * c).astype(dt)[None, :, None, None]

    def step(state, kv_t):
        return state * chunk_decay + kv_t, state

    _, s_prev = lax.scan(step, jnp.zeros((b, h, d, d), dt), jnp.moveaxis(kv, 2, 0))
    s_prev = jnp.moveaxis(s_prev, 0, 2)
    q_decay = jnp.exp(lg[:, None] * (idx + 1.0)[None]).astype(dt)
    o_cross = jnp.einsum('bhnid,hi,bhnde->bhnie', qc, q_decay, s_prev)
    return (o_intra + o_cross).reshape(b, h, s, d)


def _hybrid_conv_retention(xn, w_in, conv_w, decay_fwd, decay_bwd, gn_w, w_out):
    b, s, _ = xn.shape
    proj = xn @ w_in
    a_b, a_c, a_h, r_q, r_k, r_v, r_g = jnp.split(proj, IN_SPLITS, axis=-1)
    u = a_c * a_h
    up = jnp.pad(u, ((0, 0), (1, 1), (0, 0)))
    conv = conv_w[0] * up[:, :-2] + conv_w[1] * up[:, 1:-1] + conv_w[2] * up[:, 2:]
    y_a = a_b * conv
    def heads(t):
        return t.reshape(b, s, RET_HEADS, RET_DIM).transpose(0, 2, 1, 3)
    q = _rope(heads(r_q))
    k = _rope(heads(r_k)) * (RET_DIM ** -0.5)
    v = heads(r_v)
    lg_f = -jnp.exp(decay_fwd.astype(F32))
    lg_b = -jnp.exp(decay_bwd.astype(F32))
    o_f = _retention_one_dir(q, k, v, lg_f, strict=False)
    o_b = jnp.flip(_retention_one_dir(jnp.flip(q, 2), jnp.flip(k, 2), jnp.flip(v, 2), lg_b, strict=True), 2)
    o = (o_f + o_b).astype(F32)
    mu = jnp.mean(o, axis=-1, keepdims=True)
    var = jnp.mean(jnp.square(o - mu), axis=-1, keepdims=True)
    o = ((o - mu) * lax.rsqrt(var + GN_EPS)).astype(xn.dtype)
    o = o.transpose(0, 2, 1, 3).reshape(b, s, RET_WIDTH) * gn_w
    y_b = jax.nn.silu(r_g) * o
    return jnp.concatenate([y_a, y_b], axis=-1) @ w_out


def _diff_attention(xn, w_qkv, lq1, lk1, lq2, lk2, subln, w_out, lambda_init):
    b, s, _ = xn.shape
    qkv = xn @ w_qkv
    q, k, v = jnp.split(qkv, [DIFF_QK, 2 * DIFF_QK], axis=-1)
    q = q.reshape(b, s, 2 * DIFF_HEADS, DIFF_DIM).transpose(0, 2, 1, 3)
    k = k.reshape(b, s, 2 * DIFF_HEADS, DIFF_DIM).transpose(0, 2, 1, 3)
    v = v.reshape(b, s, DIFF_HEADS, 2 * DIFF_DIM).transpose(0, 2, 1, 3)
    q = _rope(q) * (DIFF_DIM ** -0.5)
    k = _rope(k)
    lam = (jnp.exp(jnp.sum(lq1.astype(F32) * lk1.astype(F32)))
           - jnp.exp(jnp.sum(lq2.astype(F32) * lk2.astype(F32))) + lambda_init)
    nb = s // Q_BLOCK
    qb = q.reshape(b, 2 * DIFF_HEADS, nb, Q_BLOCK, DIFF_DIM).transpose(2, 0, 1, 3, 4)

    def block(qblk):
        sc = jnp.einsum('bhqd,bhkd->bhqk', qblk, k).astype(F32)
        p = jax.nn.softmax(sc, axis=-1).reshape(b, DIFF_HEADS, 2, Q_BLOCK, s)
        a = p[:, :, 0] - lam * p[:, :, 1]
        return jnp.einsum('bhqk,bhke->bhqe', a.astype(v.dtype), v)

    o = lax.map(block, qb)
    o = o.transpose(1, 2, 0, 3, 4).reshape(b, DIFF_HEADS, s, 2 * DIFF_DIM)
    o = _rmsnorm(o, subln, SUBLN_EPS) * (1.0 - lambda_init)
    o = o.transpose(0, 2, 1, 3).reshape(b, s, DIFF_V)
    return o @ w_out


def _swiglu(xn, w_gate, w_up, w_down):
    return (jax.nn.silu(xn @ w_gate) * (xn @ w_up)) @ w_down


def _trunk(x, norm_mix, norm_ffn, norm_final, hyb_w_in, hyb_conv_w, hyb_decay_fwd, hyb_decay_bwd,
           hyb_gn, hyb_w_out, diff_w_qkv, diff_lq1, diff_lk1, diff_lq2, diff_lk2, diff_subln,
           diff_w_out, ffn_w_gate, ffn_w_up, ffn_w_down):
    for layer in range(DEPTH):
        xn = _rmsnorm(x, norm_mix[layer])
        if layer % 2 == 0:
            e = layer // 2
            x = x + _hybrid_conv_retention(xn, hyb_w_in[e], hyb_conv_w[e], hyb_decay_fwd[e],
                                           hyb_decay_bwd[e], hyb_gn[e], hyb_w_out[e])
        else:
            o = layer // 2
            lambda_init = 0.8 - 0.6 * math.exp(-0.3 * layer)
            x = x + _diff_attention(xn, diff_w_qkv[o], diff_lq1[o], diff_lk1[o], diff_lq2[o],
                                    diff_lk2[o], diff_subln[o], diff_w_out[o], lambda_init)
        x = x + _swiglu(_rmsnorm(x, norm_ffn[layer]), ffn_w_gate[layer], ffn_w_up[layer], ffn_w_down[layer])
    return _rmsnorm(x, norm_final)


def setup_inputs(seed: int = 0) -> dict:
    key = jax.random.key(seed)
    ks = jax.random.split(key, 24)

    def nrm(k, shape, fan_in):
        return jax.random.normal(k, shape, F32) * (fan_in ** -0.5)

    def gain(k, shape):
        return 1.0 + 0.02 * jax.random.normal(k, shape, F32)

    base_decay = jnp.log(-jnp.log1p(-(2.0 ** (-5.0 - jnp.arange(RET_HEADS, dtype=F32)))))
    return {
        "x_prompt": jax.random.normal(ks[0], (BATCH, SEQ, D_MODEL), F32),
        "x_sample": jax.random.normal(ks[1], (DEC_BATCH, DEC_SEQ, D_MODEL), F32),
        "norm_mix": gain(ks[2], (DEPTH, D_MODEL)),
        "norm_ffn": gain(ks[3], (DEPTH, D_MODEL)),
        "norm_final": gain(ks[4], (D_MODEL,)),
        "hyb_w_in": nrm(ks[5], (N_EVEN, D_MODEL, IN_PROJ_COLS), D_MODEL),
        "hyb_conv_w": nrm(ks[6], (N_EVEN, CONV_W, CONV_CH), CONV_W),
        "hyb_decay_fwd": base_decay[None] + 0.05 * jax.random.normal(ks[7], (N_EVEN, RET_HEADS), F32),
        "hyb_decay_bwd": base_decay[None] + 0.05 * jax.random.normal(ks[8], (N_EVEN, RET_HEADS), F32),
        "hyb_gn": gain(ks[9], (N_EVEN, RET_WIDTH)),
        "hyb_w_out": nrm(ks[10], (N_EVEN, CONV_CH + RET_WIDTH, D_MODEL), CONV_CH + RET_WIDTH),
        "diff_w_qkv": nrm(ks[11], (N_ODD, D_MODEL, 2 * DIFF_QK + DIFF_V), D_MODEL),
        "diff_lq1": 0.1 * jax.random.normal(ks[12], (N_ODD, DIFF_DIM), F32),
        "diff_lk1": 0.1 * jax.random.normal(ks[13], (N_ODD, DIFF_DIM), F32),
        "diff_lq2": 0.1 * jax.random.normal(ks[14], (N_ODD, DIFF_DIM), F32),
        "diff_lk2": 0.1 * jax.random.normal(ks[15], (N_ODD, DIFF_DIM), F32),
        "diff_subln": gain(ks[16], (N_ODD, 2 * DIFF_DIM)),
        "diff_w_out": nrm(ks[17], (N_ODD, DIFF_V, D_MODEL), DIFF_V),
        "ffn_w_gate": nrm(ks[18], (DEPTH, D_MODEL, D_FF), D_MODEL),
        "ffn_w_up": nrm(ks[19], (DEPTH, D_MODEL, D_FF), D_MODEL),
        "ffn_w_down": nrm(ks[20], (DEPTH, D_FF, D_MODEL), D_FF),
    }


def reference(x_prompt, x_sample, norm_mix, norm_ffn, norm_final, hyb_w_in, hyb_conv_w,
              hyb_decay_fwd, hyb_decay_bwd, hyb_gn, hyb_w_out, diff_w_qkv, diff_lq1, diff_lk1,
              diff_lq2, diff_lk2, diff_subln, diff_w_out, ffn_w_gate, ffn_w_up, ffn_w_down):
    y_prompt = _trunk(x_prompt, norm_mix, norm_ffn, norm_final, hyb_w_in, hyb_conv_w, hyb_decay_fwd,
                      hyb_decay_bwd, hyb_gn, hyb_w_out, diff_w_qkv, diff_lq1, diff_lk1, diff_lq2,
                      diff_lk2, diff_subln, diff_w_out, ffn_w_gate, ffn_w_up, ffn_w_down)
    y_sample = _trunk(x_sample, norm_mix, norm_ffn, norm_final, hyb_w_in, hyb_conv_w, hyb_decay_fwd,
                      hyb_decay_bwd, hyb_gn, hyb_w_out, diff_w_qkv, diff_lq1, diff_lk1, diff_lq2,
                      diff_lk2, diff_subln, diff_w_out, ffn_w_gate, ffn_w_up, ffn_w_down)
    return (y_prompt, y_sample)
```

```cpp
#include <hip/hip_runtime.h>
#include <hip/hip_cooperative_groups.h>
#include <cstdio>
#include <cstdint>
namespace cg = cooperative_groups;
#ifndef MK_MULTI
#define MK_MULTI 0
#endif
namespace pg8 {
#define PG8_LAS __attribute__((address_space(3)))
typedef unsigned short bf16_t;
typedef short bf16x8 __attribute__((ext_vector_type(8)));
typedef float f32x4 __attribute__((ext_vector_type(4)));
typedef unsigned u32x4 __attribute__((ext_vector_type(4)));
constexpr int BM = 256, BK = 64, HALF = 128, HTB = HALF * BK * 2  , STAGE_BYTES = 8 * HTB, NXCD = 8, WGM = 8;

__host__ __device__ __forceinline__ int lds_byte(int r, int c) { const int st = (r >> 4) * 2 + (c >> 5), rr = r & 15, cc = c & 31, ob = rr * 64 + cc * 2; return st * 1024 + (ob ^ (((ob >> 9) & 1) << 5)); }
__host__ __device__ __forceinline__ void stage_rc(int b, int& R, int& C) { const int st = b / 1024, sb = b % 1024, swz = sb ^ (((sb >> 9) & 1) << 5); R = (st >> 1) * 16 + swz / 64; C = (st & 1) * 32 + (swz % 64) / 2; }
__host__ __device__ __forceinline__ int perm32(int rho) { const int n = rho >> 4, i = rho & 15; return 8 * (i >> 2) + 4 * n + (i & 3); }

struct Unit { int pm, pn; };
struct Gemm { const bf16_t* A; const bf16_t* Bt; int M, N, K, lda; };

struct StaticOrder {
    int nM, nN, nwg, G, c;
    __host__ __device__ void init(int M, int N, int G_, int c_) { nM = M / BM; nN = N / BM; nwg = nM * nN; G = G_; c = c_; }
    __host__ __device__ bool next(int i, Unit& u) const {
        const long L = (long)i * G + c; if (L >= nwg) return false;
        int wgid = (int)L; { const int q = nwg / NXCD, r = nwg % NXCD, xcd = wgid % NXCD, off = wgid / NXCD; wgid = (xcd < r ? xcd * (q + 1) : r * (q + 1) + (xcd - r) * q) + off; }
        const int nig = WGM * nN, gid = wgid / nig, fm = gid * WGM, gsz = (nM - fm) < WGM ? (nM - fm) : WGM;
        u.pm = fm + ((wgid % nig) % gsz); u.pn = (wgid % nig) / gsz; return true;
    }
    __device__ __forceinline__ void a_ready(const Unit&) const {}
    __device__ __forceinline__ void done(const Unit&) const {}
};

template <class Epi, class Sched, bool ALIGN_EPI = false, bool SP2 = false>
__device__ __forceinline__ void gemm_phase(PG8_LAS unsigned char* lds, const Gemm g, const Sched& S, const Epi& E) {
    const int tid = threadIdx.x, wid = __builtin_amdgcn_readfirstlane(tid >> 6), lane = tid & 63, wr = wid >> 2, wc = wid & 3, fr = lane & 15, fq = lane >> 4;
    const int K = g.K, nt = K / BK, lda = g.lda;
    unsigned voffA[2], voffB[2];
#pragma unroll
    for (int i = 0; i < 2; ++i) { int R, C; stage_rc(tid * 16 + i * 8192, R, C); const int Rb = Epi::PERM ? ((R & ~31) + perm32(R & 31)) : R;
        voffA[i] = (unsigned)(R * lda + C) * 2u; voffB[i] = (unsigned)(Rb * K + C) * 2u; }
    const size_t kstep = (size_t)(BK * 2);
    const size_t hstep = (size_t)HALF * K * 2;
    const size_t tstep = 2 * hstep; const size_t hstepA = (size_t)HALF * lda * 2, tstepA = 2 * hstepA;
    const unsigned ldsw = (unsigned)wid * 1024u;
    const int aoff = lds_byte(wr * 64 + fr, fq * 8), boff = lds_byte(wc * 32 + fr, fq * 8);
#define PG8_SA(b, h) (((b) * 2 + (h)) * HTB)
#define PG8_SB(b, h) ((4 + (b) * 2 + (h)) * HTB)
#define PG8_STAGE(bufoff, gbase, voff) do { _Pragma("unroll") for (int _i = 0; _i < 2; ++_i) \
        __builtin_amdgcn_global_load_lds((const unsigned*)((const char*)(gbase) + (voff)[_i]), (PG8_LAS unsigned*)(lds + (bufoff) + ldsw + _i * 8192), 16, 0, 0); } while (0)
#define PG8_LDA(dst, b, h) do { _Pragma("unroll") for (int m = 0; m < 4; ++m) _Pragma("unroll") for (int k = 0; k < 2; ++k) dst[m][k] = *(const PG8_LAS bf16x8*)(lds + PG8_SA(b, h) + aoff + m * 2048 + k * 1024); } while (0)
#define PG8_LDB(dst, b, h) do { _Pragma("unroll") for (int n = 0; n < 2; ++n) _Pragma("unroll") for (int k = 0; k < 2; ++k) dst[n][k] = *(const PG8_LAS bf16x8*)(lds + PG8_SB(b, h) + boff + n * 2048 + k * 1024); } while (0)
#define PG8_MMA(ai, bj, At, Bt) do { __builtin_amdgcn_s_setprio(1); _Pragma("unroll") for (int m = 0; m < 4; ++m) _Pragma("unroll") for (int n = 0; n < 2; ++n) _Pragma("unroll") for (int k = 0; k < 2; ++k) \
        acc[ai][bj][m][n] = __builtin_amdgcn_mfma_f32_16x16x32_bf16(Bt[n][k], At[m][k], acc[ai][bj][m][n], 0, 0, 0); __builtin_amdgcn_s_setprio(0); } while (0)
#define PG8_WAIT_V(n) asm volatile("s_waitcnt vmcnt(" #n ")" ::: "memory")
#define PG8_WAIT_L(n) asm volatile("s_waitcnt lgkmcnt(" #n ")" ::: "memory")
#define PG8_BAR __builtin_amdgcn_s_barrier()
#define PG8_SCHED __builtin_amdgcn_sched_barrier(0)
    Unit cur, nxt; int ui = 0;
    if (!S.next(0, cur)) return;
    f32x4 acc[2][2][4][2];
#pragma unroll
    for (int a = 0; a < 2; ++a)
#pragma unroll
        for (int b = 0; b < 2; ++b)
#pragma unroll
            for (int m = 0; m < 4; ++m)
#pragma unroll
                for (int n = 0; n < 2; ++n) acc[a][b][m][n] = (f32x4){0.f, 0.f, 0.f, 0.f};
    bf16x8 At[4][2], B0[2][2], B1[2][2];
    const char* cA = (const char*)g.A + (size_t)cur.pm * tstepA; const char* cB = (const char*)g.Bt + (size_t)cur.pn * tstep;
    S.a_ready(cur);
    if constexpr (SP2) {
        PG8_STAGE(PG8_SB(0, 0), cB, voffB); PG8_STAGE(PG8_SB(0, 1), cB + hstep, voffB); PG8_STAGE(PG8_SA(0, 0), cA, voffA); PG8_STAGE(PG8_SA(0, 1), cA + hstepA, voffA);
        if (wr == 1) PG8_BAR;
        PG8_WAIT_V(2); PG8_BAR;
        PG8_STAGE(PG8_SB(1, 0), cB + kstep, voffB); PG8_STAGE(PG8_SA(1, 0), cA + kstep, voffA); PG8_STAGE(PG8_SB(1, 1), cB + hstep + kstep, voffB);
        PG8_WAIT_V(6); PG8_BAR;
    } else {
        PG8_STAGE(PG8_SB(0, 0), cB, voffB); PG8_STAGE(PG8_SA(0, 0), cA, voffA); PG8_STAGE(PG8_SB(0, 1), cB + hstep, voffB); PG8_STAGE(PG8_SA(0, 1), cA + hstepA, voffA);
        if (wr == 1) PG8_BAR;
        PG8_WAIT_V(4); PG8_BAR;
        PG8_STAGE(PG8_SB(1, 0), cB + kstep, voffB); PG8_STAGE(PG8_SA(1, 0), cA + kstep, voffA); PG8_STAGE(PG8_SB(1, 1), cB + hstep + kstep, voffB);
        PG8_WAIT_V(6); PG8_BAR;
    }
    for (;;) {
        const bool has_next = S.next(ui + 1, nxt);
        const char* nA = has_next ? (const char*)g.A + (size_t)nxt.pm * tstepA : cA; const char* nB = has_next ? (const char*)g.Bt + (size_t)nxt.pn * tstep : cB;
        for (int t = 0; t < nt; t += 2) {
            const bool last = (t == nt - 2);
            const char* a1 = cA + (size_t)(t + 1) * kstep;
            const char* a2 = last ? nA : cA + (size_t)(t + 2) * kstep; const char* b2 = last ? nB : cB + (size_t)(t + 2) * kstep;
            const char* a3 = a2 + kstep; const char* b3 = b2 + kstep;
            if (last && has_next) S.a_ready(nxt);
            if constexpr (SP2) {
            PG8_LDB(B0, 0, 0); PG8_LDB(B1, 0, 1); PG8_SCHED; PG8_LDA(At, 0, 0); PG8_STAGE(PG8_SA(1, 1), a1 + hstepA, voffA);
            PG8_WAIT_V(8); PG8_WAIT_L(0); PG8_BAR; PG8_MMA(0, 0, At, B0); PG8_MMA(0, 1, At, B1); PG8_BAR; PG8_SCHED;
            PG8_LDA(At, 0, 1); PG8_STAGE(PG8_SB(0, 0), b2, voffB); PG8_STAGE(PG8_SB(0, 1), b2 + hstep, voffB); PG8_STAGE(PG8_SA(0, 0), a2, voffA);
            PG8_WAIT_V(8); PG8_WAIT_L(0); PG8_BAR; PG8_MMA(1, 0, At, B0); PG8_MMA(1, 1, At, B1); PG8_BAR; PG8_SCHED;
            PG8_LDB(B0, 1, 0); PG8_LDB(B1, 1, 1); PG8_SCHED; PG8_LDA(At, 1, 0); PG8_STAGE(PG8_SA(0, 1), a2 + hstepA, voffA);
            PG8_WAIT_V(8); PG8_WAIT_L(0); PG8_BAR; PG8_MMA(0, 0, At, B0); PG8_MMA(0, 1, At, B1); PG8_BAR; PG8_SCHED;
            PG8_LDA(At, 1, 1); PG8_STAGE(PG8_SB(1, 0), b3, voffB); PG8_STAGE(PG8_SB(1, 1), b3 + hstep, voffB); PG8_STAGE(PG8_SA(1, 0), a3, voffA);
            PG8_WAIT_V(8); PG8_WAIT_L(0); PG8_BAR; PG8_MMA(1, 0, At, B0); PG8_MMA(1, 1, At, B1); PG8_BAR; PG8_SCHED;
            } else {
            PG8_LDB(B0, 0, 0); PG8_SCHED; PG8_LDA(At, 0, 0); PG8_STAGE(PG8_SA(1, 1), a1 + hstepA, voffA);
            PG8_WAIT_L(8); PG8_BAR; PG8_WAIT_L(0); PG8_MMA(0, 0, At, B0); PG8_BAR; PG8_SCHED;
            PG8_LDB(B1, 0, 1); PG8_STAGE(PG8_SB(0, 0), b2, voffB);
            PG8_BAR; PG8_WAIT_L(0); PG8_MMA(0, 1, At, B1); PG8_BAR;
            PG8_LDA(At, 0, 1); PG8_STAGE(PG8_SA(0, 0), a2, voffA);
            PG8_BAR; PG8_WAIT_L(0); PG8_MMA(1, 0, At, B0); PG8_BAR; PG8_SCHED;
            PG8_STAGE(PG8_SB(0, 1), b2 + hstep, voffB);
            PG8_WAIT_V(6); PG8_BAR; PG8_MMA(1, 1, At, B1); PG8_BAR;
            PG8_LDB(B0, 1, 0); PG8_SCHED; PG8_LDA(At, 1, 0); PG8_STAGE(PG8_SA(0, 1), a2 + hstepA, voffA);
            PG8_WAIT_L(8); PG8_BAR; PG8_WAIT_L(0); PG8_MMA(0, 0, At, B0); PG8_BAR; PG8_SCHED;
            PG8_LDB(B1, 1, 1); PG8_STAGE(PG8_SB(1, 0), b3, voffB);
            PG8_BAR; PG8_WAIT_L(0); PG8_MMA(0, 1, At, B1); PG8_BAR;
            PG8_LDA(At, 1, 1); PG8_STAGE(PG8_SA(1, 0), a3, voffA);
            PG8_BAR; PG8_WAIT_L(0); PG8_MMA(1, 0, At, B0); PG8_BAR; PG8_SCHED;
            PG8_STAGE(PG8_SB(1, 1), b3 + hstep, voffB);
            PG8_WAIT_V(6); PG8_BAR; PG8_MMA(1, 1, At, B1); PG8_BAR;
            }
        }
        if constexpr (ALIGN_EPI) { if (wr == 0) PG8_BAR; }
        if constexpr (!Epi::AFTER_DRAIN) { E(acc, cur, wr, wc, fr, fq); S.done(cur); }
        if (!has_next) break;
#pragma unroll
        for (int a = 0; a < 2; ++a)
#pragma unroll
            for (int b = 0; b < 2; ++b)
#pragma unroll
                for (int m = 0; m < 4; ++m)
#pragma unroll
                    for (int n = 0; n < 2; ++n) acc[a][b][m][n] = (f32x4){0.f, 0.f, 0.f, 0.f};
        cur = nxt; cA = nA; cB = nB; ++ui;
        if constexpr (ALIGN_EPI) { if (wr == 1) PG8_BAR; }
    }
    PG8_WAIT_V(0);
    if constexpr (!ALIGN_EPI) { if (wr == 0) PG8_BAR; }
    PG8_BAR;
    if constexpr (Epi::AFTER_DRAIN) { E.fused(acc, cur, wr, wc, fr, fq, lds, wid, lane); S.done(cur); }
#undef PG8_SA
#undef PG8_SB
#undef PG8_STAGE
#undef PG8_LDA
#undef PG8_LDB
#undef PG8_MMA
#undef PG8_WAIT_V
#undef PG8_WAIT_L
#undef PG8_BAR
#undef PG8_SCHED
}
}

#define LAS __attribute__((address_space(3)))
typedef unsigned short bf16_t;
typedef short bf16x8 __attribute__((ext_vector_type(8)));
typedef short s16x4 __attribute__((ext_vector_type(4)));
typedef short v4i16_t __attribute__((ext_vector_type(4)));
typedef float f32x2 __attribute__((ext_vector_type(2)));
typedef float f32x4 __attribute__((ext_vector_type(4)));
typedef float f32x16 __attribute__((ext_vector_type(16)));
typedef __bf16 bf16x2_t __attribute__((ext_vector_type(2)));
typedef unsigned u32x2 __attribute__((ext_vector_type(2)));
typedef unsigned u32x4 __attribute__((ext_vector_type(4)));

constexpr int DM = 1024, TP = 32768, TS = 65536, T = TP + TS, SP = 16384, SSQ = 8192;
constexpr int DFF = 2816, NGU = 2 * DFF, NIN = 3584, NQKV = 3072, PW = 3072;
constexpr int NUNITS_RET = (T / 128) * 4;
constexpr float LOG2E = 1.4426950408889634f;
constexpr float LAMBDA_INIT = 0.35550906758f;
constexpr int PC_AB = 0, PC_SG = 512, PC_U = 1024, PC_Q = 1536, PC_K = 2048, PC_V = 2560;

constexpr size_t MiB = 1u << 20;
constexpr size_t WS_WIN = 1 * MiB, WS_WOUT0 = 8 * MiB, WS_WGU0 = 10 * MiB, WS_WD0 = 21 * MiB, WS_WQKV = 27 * MiB, WS_WO1 = 33 * MiB, WS_WGU1 = 35 * MiB, WS_WD1 = 46 * MiB;
constexpr size_t WS_TAB128 = 52 * MiB, WS_TAB64 = 60 * MiB, WS_PART = 64 * MiB, WS_XN = 72 * MiB, WS_BIG = 264 * MiB, WS_END = 840 * MiB;
static_assert(WS_XN + (size_t)T * DM * 2 <= WS_BIG && WS_BIG + (size_t)T * PW * 2 <= WS_END, "ws map");
static_assert((size_t)2 * NUNITS_RET * 16384 * 2 <= (size_t)T * DM * 2, "retention states alias XN");
constexpr int LDS_BYTES = 148480;

__device__ __forceinline__ unsigned pk2(float lo, float hi) { f32x2 v = {lo, hi}; bf16x2_t b = __builtin_convertvector(v, bf16x2_t); return __builtin_bit_cast(unsigned, b); }
__device__ __forceinline__ float bflo(unsigned u) { return __uint_as_float(u << 16); }
__device__ __forceinline__ float bfhi(unsigned u) { return __uint_as_float(u & 0xffff0000u); }
__device__ __forceinline__ float silu_f(float x) { return x * __builtin_amdgcn_rcpf(1.f + __expf(-x)); }
__device__ __forceinline__ int tok_pos(int row) { return row < TP ? (row & (SP - 1)) : (row & (SSQ - 1)); }
__device__ __forceinline__ s16x4 ldtr(const LAS unsigned char* p) { return __builtin_bit_cast(s16x4, __builtin_amdgcn_ds_read_tr16_b64_v4i16((LAS v4i16_t*)p)); }
__device__ __forceinline__ bf16x8 cat8(s16x4 a, s16x4 b) { return (bf16x8){a[0], a[1], a[2], a[3], b[0], b[1], b[2], b[3]}; }
__device__ __forceinline__ float wave_sum(float v) {
#pragma unroll
    for (int o = 1; o < 64; o <<= 1) v += __shfl_xor(v, o);
    return v;
}
__device__ __forceinline__ float row_scale(const float* part, int row) {
    const f32x4* p = (const f32x4*)(part + (size_t)row * 16);
    const f32x4 a = p[0], b = p[1], c = p[2], d = p[3];
    const float s = ((a[0] + a[1]) + (a[2] + a[3])) + ((b[0] + b[1]) + (b[2] + b[3])) + ((c[0] + c[1]) + (c[2] + c[3])) + ((d[0] + d[1]) + (d[2] + d[3]));
    return __builtin_amdgcn_rsqf(s * (1.0f / 1024.0f) + 1e-6f);
}

struct EpiInProj {
    static constexpr bool PERM = true, AFTER_DRAIN = false;
    bf16_t* O; const float* tab;
    __device__ __forceinline__ void operator()(const pg8::f32x4 (&acc)[2][2][4][2], const pg8::Unit& u, int wr, int wc, int fr, int fq) const {
        const int pn = u.pn, row0 = u.pm * 256 + wr * 64 + fr;
        if (pn < 4 || pn >= 12) {
            const bool sl = (pn >= 2 && pn < 4);
            const int oc = (pn < 4 ? pn * 256 : PC_V + (pn - 12) * 256) + wc * 32 + 8 * fq;
#pragma unroll
            for (int ai = 0; ai < 2; ++ai)
#pragma unroll
                for (int m = 0; m < 4; ++m) { bf16_t* rp = O + (size_t)(row0 + ai * 128 + m * 16) * PW + oc;
#pragma unroll
                    for (int bj = 0; bj < 2; ++bj) { f32x4 v0 = acc[ai][bj][m][0], v1 = acc[ai][bj][m][1];
                        if (sl) { v0 = (f32x4){silu_f(v0[0]), silu_f(v0[1]), silu_f(v0[2]), silu_f(v0[3])}; v1 = (f32x4){silu_f(v1[0]), silu_f(v1[1]), silu_f(v1[2]), silu_f(v1[3])}; }
                        u32x4 w; w.x = pk2(v0[0], v0[1]); w.y = pk2(v0[2], v0[3]); w.z = pk2(v1[0], v1[1]); w.w = pk2(v1[2], v1[3]);
                        *(u32x4*)(rp + bj * 128) = w; } }
        } else if (pn < 8) {
            const int oc = PC_U + (pn - 4) * 128 + wc * 16 + 4 * fq;
#pragma unroll
            for (int ai = 0; ai < 2; ++ai)
#pragma unroll
                for (int m = 0; m < 4; ++m) { bf16_t* rp = O + (size_t)(row0 + ai * 128 + m * 16) * PW + oc;
#pragma unroll
                    for (int bj = 0; bj < 2; ++bj) { const f32x4 v = acc[ai][bj][m][0] * acc[ai][bj][m][1];
                        u32x2 w; w.x = pk2(v[0], v[1]); w.y = pk2(v[2], v[3]); *(u32x2*)(rp + bj * 64) = w; } }
        } else {
            const bool isk = pn >= 10; const float sc = isk ? 0.08838834764831845f : 1.0f;
            const int oc = (isk ? PC_K + (pn - 10) * 256 : PC_Q + (pn - 8) * 256) + wc * 32 + 8 * fq;
            const int f0 = 4 * (4 * wc + fq);
#pragma unroll
            for (int ai = 0; ai < 2; ++ai)
#pragma unroll
                for (int m = 0; m < 4; ++m) { const int row = row0 + ai * 128 + m * 16; const f32x4* tp = (const f32x4*)(tab + ((size_t)tok_pos(row) * 64 + f0) * 2);
                    const f32x4 t0 = tp[0], t1 = tp[1]; const f32x4 cs = {t0[0], t0[2], t1[0], t1[2]}, sn = {t0[1], t0[3], t1[1], t1[3]};
                    bf16_t* rp = O + (size_t)row * PW + oc;
#pragma unroll
                    for (int bj = 0; bj < 2; ++bj) { const f32x4 x1 = acc[ai][bj][m][0], x2 = acc[ai][bj][m][1];
                        const f32x4 o1 = (x1 * cs - x2 * sn) * sc, o2 = (x1 * sn + x2 * cs) * sc;
                        u32x4 w; w.x = pk2(o1[0], o1[1]); w.y = pk2(o1[2], o1[3]); w.z = pk2(o2[0], o2[1]); w.w = pk2(o2[2], o2[3]);
                        *(u32x4*)(rp + bj * 128) = w; } }
        }
    }
};
struct EpiQKV {
    static constexpr bool PERM = true, AFTER_DRAIN = false;
    bf16_t* O; const float* tab; const float* part; unsigned* kmax;
    __device__ __forceinline__ void operator()(const pg8::f32x4 (&acc)[2][2][4][2], const pg8::Unit& u, int wr, int wc, int fr, int fq) const {
        const int pn = u.pn, row0 = u.pm * 256 + wr * 64 + fr;
        const int oc = pn * 256 + wc * 32 + 8 * fq;
        if (pn >= 8) {
#pragma unroll
            for (int ai = 0; ai < 2; ++ai)
#pragma unroll
                for (int m = 0; m < 4; ++m) { const int row = row0 + ai * 128 + m * 16; const float rs = row_scale(part, row);
                    bf16_t* rp = O + (size_t)T * 1024 + ((size_t)(2 * (pn - 8)) * T + row) * 256 + 128 + wc * 32 + 8 * fq;
#pragma unroll
                    for (int bj = 0; bj < 2; ++bj) { const f32x4 v0 = acc[ai][bj][m][0] * rs, v1 = acc[ai][bj][m][1] * rs;
                        u32x4 w; w.x = pk2(v0[0], v0[1]); w.y = pk2(v0[2], v0[3]); w.z = pk2(v1[0], v1[1]); w.w = pk2(v1[2], v1[3]);
                        *(u32x4*)(rp + (size_t)bj * T * 256) = w; } }
        } else {
            const float sc = pn < 4 ? 0.125f * LOG2E : 1.0f;
            const int f0 = 4 * (4 * (wc & 1) + fq);
            float kmx0 = 0.f, kmx1 = 0.f;
#pragma unroll
            for (int ai = 0; ai < 2; ++ai)
#pragma unroll
                for (int m = 0; m < 4; ++m) { const int row = row0 + ai * 128 + m * 16; const float rs = row_scale(part, row) * sc;
                    const f32x4* tp = (const f32x4*)(tab + ((size_t)tok_pos(row) * 32 + f0) * 2);
                    const f32x4 t0 = tp[0], t1 = tp[1]; const f32x4 cs = {t0[0], t0[2], t1[0], t1[2]}, sn = {t0[1], t0[3], t1[1], t1[3]};
                    bf16_t* rp = pn < 4 ? O + (size_t)row * 1024 + oc : O + (size_t)T * 1024 + ((size_t)(2 * (pn - 4)) * T + row) * 256 + wc * 32 + 8 * fq;
                    const size_t bjs = pn < 4 ? (size_t)128 : (size_t)T * 256;
#pragma unroll
                    for (int bj = 0; bj < 2; ++bj) { const f32x4 x1 = acc[ai][bj][m][0], x2 = acc[ai][bj][m][1];
                        const f32x4 o1 = (x1 * cs - x2 * sn) * rs, o2 = (x1 * sn + x2 * cs) * rs;
                        u32x4 w; w.x = pk2(o1[0], o1[1]); w.y = pk2(o1[2], o1[3]); w.z = pk2(o2[0], o2[1]); w.w = pk2(o2[2], o2[3]);
                        *(u32x4*)(rp + bj * bjs) = w;
                        if (pn >= 4) { float q2 = ((o1[0] * o1[0] + o1[1] * o1[1]) + (o1[2] * o1[2] + o1[3] * o1[3])) + ((o2[0] * o2[0] + o2[1] * o2[1]) + (o2[2] * o2[2] + o2[3] * o2[3]));
                            q2 += __shfl_xor(q2, 16); q2 += __shfl_xor(q2, 32);
                            if (bj == 0) kmx0 = fmaxf(kmx0, q2); else kmx1 = fmaxf(kmx1, q2); } } }
            if (pn >= 4) {
#pragma unroll
                for (int o_ = 1; o_ < 16; o_ <<= 1) { kmx0 = fmaxf(kmx0, __shfl_xor(kmx0, o_)); kmx1 = fmaxf(kmx1, __shfl_xor(kmx1, o_)); }
                const int r0 = u.pm * 256, seq = r0 < TP ? (r0 >> 14) : 2 + ((r0 - TP) >> 13);
                if (fr == 0 && fq == 0) {
                    __hip_atomic_fetch_max(kmax + ((seq * 16 + 4 * (pn - 4) + (wc >> 1)) * 2 + (wc & 1)), __float_as_uint(kmx0 * 1.02f), __ATOMIC_RELAXED, __HIP_MEMORY_SCOPE_AGENT);
                    __hip_atomic_fetch_max(kmax + ((seq * 16 + 4 * (pn - 4) + 2 + (wc >> 1)) * 2 + (wc & 1)), __float_as_uint(kmx1 * 1.02f), __ATOMIC_RELAXED, __HIP_MEMORY_SCOPE_AGENT); }
            }
        }
    }
};
struct EpiGU {
    static constexpr bool PERM = true, AFTER_DRAIN = false;
    bf16_t* H; const float* part;
    __device__ __forceinline__ void operator()(const pg8::f32x4 (&acc)[2][2][4][2], const pg8::Unit& u, int wr, int wc, int fr, int fq) const {
        const int row0 = u.pm * 256 + wr * 64 + fr, oc = u.pn * 128 + wc * 16 + 4 * fq;
#pragma unroll
        for (int ai = 0; ai < 2; ++ai)
#pragma unroll
            for (int m = 0; m < 4; ++m) { const int row = row0 + ai * 128 + m * 16; const float rs = row_scale(part, row); bf16_t* rp = H + (size_t)row * DFF + oc;
#pragma unroll
                for (int bj = 0; bj < 2; ++bj) { const f32x4 g = acc[ai][bj][m][0] * rs, up = acc[ai][bj][m][1] * rs;
                    const f32x4 hh = {silu_f(g[0]) * up[0], silu_f(g[1]) * up[1], silu_f(g[2]) * up[2], silu_f(g[3]) * up[3]};
                    u32x2 w; w.x = pk2(hh[0], hh[1]); w.y = pk2(hh[2], hh[3]); *(u32x2*)(rp + bj * 64) = w; } }
    }
};
template <bool RES_F32> struct EpiRes {
    static constexpr bool PERM = false, AFTER_DRAIN = false;
    const float* res0; const float* res1; bf16_t* X; float* part;
    __device__ __forceinline__ void operator()(const pg8::f32x4 (&acc)[2][2][4][2], const pg8::Unit& u, int wr, int wc, int fr, int fq) const {
        const int col0 = u.pn * 256 + wc * 32 + 4 * fq;
#pragma unroll
        for (int ai = 0; ai < 2; ++ai)
#pragma unroll
            for (int m = 0; m < 4; ++m) { const int row = u.pm * 256 + ai * 128 + wr * 64 + m * 16 + fr;
                const float* rb = (row < TP ? res0 : res1) + (size_t)row * DM; bf16_t* xr = X + (size_t)row * DM; float ss = 0.f;
#pragma unroll
                for (int bj = 0; bj < 2; ++bj)
#pragma unroll
                    for (int n = 0; n < 2; ++n) { const int col = col0 + bj * 128 + n * 16;
                        f32x4 r;
                        if (RES_F32) r = *(const f32x4*)(rb + col);
                        else { const u32x2 rw = *(const u32x2*)(xr + col); r = (f32x4){bflo(rw.x), bfhi(rw.x), bflo(rw.y), bfhi(rw.y)}; }
                        const f32x4 x = r + acc[ai][bj][m][n];
                        ss += (x[0] * x[0] + x[1] * x[1]) + (x[2] * x[2] + x[3] * x[3]);
                        u32x2 o; o.x = pk2(x[0], x[1]); o.y = pk2(x[2], x[3]); *(u32x2*)(xr + col) = o; }
                ss += __shfl_xor(ss, 16); ss += __shfl_xor(ss, 32); if (fq == 0) part[(size_t)row * 16 + u.pn * 4 + wc] = ss; }
    }
};

enum { MAP_ID = 0, MAP_INPROJ = 1, MAP_GATE = 2, MAP_UP = 3, MAP_QKV = 4 };
__device__ __forceinline__ int dest_row(int map, int n) {
    if (map == MAP_ID) return n;
    if (map == MAP_GATE) return 8 * (n >> 2) + (n & 3);
    if (map == MAP_UP) return 8 * (n >> 2) + 4 + (n & 3);
    if (map == MAP_INPROJ) {
        const int s = n >> 9, o = n & 511;
        if (s == 0) return o;
        if (s == 6) return 512 + o;
        if (s == 1) return 1024 + 8 * (o >> 2) + (o & 3);
        if (s == 2) return 1024 + 8 * (o >> 2) + 4 + (o & 3);
        if (s == 5) return 3072 + o;
        const int hh = o >> 7, d = o & 127, half = d >> 6, f = d & 63;
        return (s == 3 ? 2048 : 2560) + 128 * hh + 8 * (f >> 2) + 4 * half + (f & 3);
    }
    if (n >= 2048) return n;
    { const int hh = n >> 6, d = n & 63, half = d >> 5, f = d & 31; return 64 * hh + 8 * (f >> 2) + 4 * half + (f & 3); }
}
__device__ __forceinline__ void p0_transpose_item(const float* W, int K, int N, bf16_t* WT, int map, LAS float* scr, int item, int lane, const float* ksc = nullptr) {
    const int nblk = N / 32, kb = item / nblk, nb = item % nblk, k0 = 64 * kb, n0 = 32 * nb;
#pragma unroll 8
    for (int i = 0; i < 32; ++i) { const int kk = 2 * i + (lane >> 5); scr[kk * 33 + (lane & 31)] = W[(size_t)(k0 + kk) * N + n0 + (lane & 31)] * (ksc ? ksc[k0 + kk] : 1.0f); }
    asm volatile("s_waitcnt lgkmcnt(0)" ::: "memory");
    const int c = lane & 7;
#pragma unroll
    for (int j = 0; j < 4; ++j) { const int n = (lane >> 3) + 8 * j; const LAS float* s = scr + (8 * c) * 33 + n;
        u32x4 o; o.x = pk2(s[0 * 33], s[1 * 33]); o.y = pk2(s[2 * 33], s[3 * 33]); o.z = pk2(s[4 * 33], s[5 * 33]); o.w = pk2(s[6 * 33], s[7 * 33]);
        *(u32x4*)(WT + (size_t)dest_row(map, n0 + n) * K + k0 + 8 * c) = o; }
    asm volatile("s_waitcnt lgkmcnt(0)" ::: "memory");
}

struct Args {
    const float* in[21]; float* out; unsigned char* ws; int ph_lo, ph_hi, coop, pad;
};

__device__ __forceinline__ void phase_prologue(const Args& a, LAS unsigned char* L, int vcu, int G) {
    const int tid = threadIdx.x, lane = tid & 63, wave = __builtin_amdgcn_readfirstlane(tid >> 6);
    LAS float* scr = (LAS float*)(L + wave * 16384);
    const int gw = vcu * 8 + wave, NGW = G * 8;
    unsigned char* ws = a.ws;
    constexpr int I_IN = 16 * (NIN / 32), I_SQ = 16 * 32, I_GU = 16 * (DFF / 32), I_DN = (DFF / 64) * 32, I_QKV = 16 * (NQKV / 32);
    constexpr int NITEMS = I_IN + I_SQ + 2 * I_GU + I_DN + I_QKV + I_SQ + 2 * I_GU + I_DN;
    for (int it = gw; it < NITEMS; it += NGW) {
        int r = it;
        if (r < I_IN) { p0_transpose_item(a.in[5], DM, NIN, (bf16_t*)(ws + WS_WIN), MAP_INPROJ, scr, r, lane, a.in[2]); continue; } r -= I_IN;
        if (r < I_SQ) { p0_transpose_item(a.in[10], DM, DM, (bf16_t*)(ws + WS_WOUT0), MAP_ID, scr, r, lane); continue; } r -= I_SQ;
        if (r < I_GU) { p0_transpose_item(a.in[18], DM, DFF, (bf16_t*)(ws + WS_WGU0), MAP_GATE, scr, r, lane, a.in[3]); continue; } r -= I_GU;
        if (r < I_GU) { p0_transpose_item(a.in[19], DM, DFF, (bf16_t*)(ws + WS_WGU0), MAP_UP, scr, r, lane, a.in[3]); continue; } r -= I_GU;
        if (r < I_DN) { p0_transpose_item(a.in[20], DFF, DM, (bf16_t*)(ws + WS_WD0), MAP_ID, scr, r, lane); continue; } r -= I_DN;
        if (r < I_QKV) { p0_transpose_item(a.in[11], DM, NQKV, (bf16_t*)(ws + WS_WQKV), MAP_QKV, scr, r, lane, a.in[2] + DM); continue; } r -= I_QKV;
        if (r < I_SQ) { p0_transpose_item(a.in[17], DM, DM, (bf16_t*)(ws + WS_WO1), MAP_ID, scr, r, lane); continue; } r -= I_SQ;
        if (r < I_GU) { p0_transpose_item(a.in[18] + (size_t)DM * DFF, DM, DFF, (bf16_t*)(ws + WS_WGU1), MAP_GATE, scr, r, lane, a.in[3] + DM); continue; } r -= I_GU;
        if (r < I_GU) { p0_transpose_item(a.in[19] + (size_t)DM * DFF, DM, DFF, (bf16_t*)(ws + WS_WGU1), MAP_UP, scr, r, lane, a.in[3] + DM); continue; } r -= I_GU;
        p0_transpose_item(a.in[20] + (size_t)DFF * DM, DFF, DM, (bf16_t*)(ws + WS_WD1), MAP_ID, scr, r, lane);
    }
    {
        const int gt = vcu * 512 + tid, NT = G * 512;
        f32x2* t128 = (f32x2*)(ws + WS_TAB128); f32x2* t64 = (f32x2*)(ws + WS_TAB64);
        for (int i = gt; i < SP * 96; i += NT) {
            int pos, f; double e; f32x2* dst;
            if (i < SP * 64) { pos = i >> 6; f = i & 63; e = (double)f * (1.0 / 64.0); dst = t128 + i; }
            else { const int j = i - SP * 64; pos = j >> 5; f = j & 31; e = (double)f * (1.0 / 32.0); dst = t64 + j; }
            const float inv = (float)exp2(-e * 13.287712379549449);
            const float angf = (float)pos * inv;
            double rev = (double)angf * 0.15915494309189535; rev -= floor(rev);
            const float rv = (float)rev;
            *dst = (f32x2){__builtin_amdgcn_cosf(rv), __builtin_amdgcn_sinf(rv)};
        }
    }
    {
        bf16_t* XN = (bf16_t*)(ws + WS_XN);
        for (int m = gw; m < T; m += NGW) {
            const float* xr = (m < TP ? a.in[0] + (size_t)m * DM : a.in[1] + (size_t)(m - TP) * DM);
            f32x4 v[4]; float s = 0.f;
#pragma unroll
            for (int j = 0; j < 4; ++j) { v[j] = ((const f32x4*)xr)[lane + 64 * j]; s += (v[j][0] * v[j][0] + v[j][1] * v[j][1]) + (v[j][2] * v[j][2] + v[j][3] * v[j][3]); }
            const float rs = __builtin_amdgcn_rsqf(wave_sum(s) * (1.f / 1024.f) + 1e-6f);
            u32x2* o8 = (u32x2*)(XN + (size_t)m * DM);
#pragma unroll
            for (int j = 0; j < 4; ++j) { const f32x4 y = v[j] * rs; u32x2 o; o.x = pk2(y[0], y[1]); o.y = pk2(y[2], y[3]); o8[lane + 64 * j] = o; }
        }
    }
}

constexpr int RP = 288, RIMG = 128 * RP;
__device__ __forceinline__ void ret_kv_unit(LAS unsigned char* L, const bf16_t* PROJ, bf16_t* ST, int u, const float* decf, const float* decb) {
    const int tid = threadIdx.x, lane = tid & 63, wid = __builtin_amdgcn_readfirstlane(tid >> 6);
    const int cgk = u >> 2, h = u & 3; const size_t row0 = (size_t)cgk * 128;
    const float l2f = -__expf(decf[h]) * LOG2E, l2b = -__expf(decb[h]) * LOG2E;
#pragma unroll
    for (int c = 0; c < 4; ++c) { const int idx = tid + 512 * c, row = idx >> 4, ch = idx & 15;
        const u32x4 kr = *(const u32x4*)(PROJ + (row0 + row) * PW + PC_K + 128 * h + 8 * ch);
        const u32x4 vr = *(const u32x4*)(PROJ + (row0 + row) * PW + PC_V + 128 * h + 8 * ch);
        const float df = __builtin_amdgcn_exp2f(l2f * (float)(127 - row)), db = __builtin_amdgcn_exp2f(l2b * (float)row);
        u32x4 kf, kb;
        kf.x = pk2(bflo(kr.x) * df, bfhi(kr.x) * df); kf.y = pk2(bflo(kr.y) * df, bfhi(kr.y) * df); kf.z = pk2(bflo(kr.z) * df, bfhi(kr.z) * df); kf.w = pk2(bflo(kr.w) * df, bfhi(kr.w) * df);
        kb.x = pk2(bflo(kr.x) * db, bfhi(kr.x) * db); kb.y = pk2(bflo(kr.y) * db, bfhi(kr.y) * db); kb.z = pk2(bflo(kr.z) * db, bfhi(kr.z) * db); kb.w = pk2(bflo(kr.w) * db, bfhi(kr.w) * db);
        *(LAS u32x4*)(L + 0 * RIMG + row * RP + ch * 16) = kf;
        *(LAS u32x4*)(L + 1 * RIMG + row * RP + ch * 16) = kb;
        *(LAS u32x4*)(L + 2 * RIMG + row * RP + ch * 16) = vr; }
    __syncthreads();
    const int dir = wid & 1, dblk = wid >> 1, li = lane & 15, dsub = (lane >> 4) & 1, hi = lane >> 5;
    const int tb = (8 * hi + (li >> 2)) * RP + (16 * dsub + 4 * (li & 3)) * 2;
    const LAS unsigned char* KA = L + dir * RIMG + tb + dblk * 64;
    const LAS unsigned char* VB = L + 2 * RIMG + tb;
    f32x16 acc[4];
#pragma unroll
    for (int e = 0; e < 4; ++e) acc[e] = (f32x16){};
#pragma unroll
    for (int st = 0; st < 8; ++st) {
        const bf16x8 af = cat8(ldtr(KA + (16 * st) * RP), ldtr(KA + (16 * st + 4) * RP));
#pragma unroll
        for (int e = 0; e < 4; ++e) { const bf16x8 bfv = cat8(ldtr(VB + (16 * st) * RP + e * 64), ldtr(VB + (16 * st + 4) * RP + e * 64));
            acc[e] = __builtin_amdgcn_mfma_f32_32x32x16_bf16(af, bfv, acc[e], 0, 0, 0); }
    }
    bf16_t* dst = ST + ((size_t)dir * NUNITS_RET + u) * 16384;
#pragma unroll
    for (int e = 0; e < 4; ++e)
#pragma unroll
        for (int r = 0; r < 16; ++r) { const int d = 32 * dblk + (r & 3) + 8 * (r >> 2) + 4 * hi;
            dst[d * 128 + 32 * e + (lane & 31)] = (bf16_t)(pk2(acc[e][r], 0.f) & 0xffffu); }
    __syncthreads();
}
__device__ __forceinline__ void phase_scan(const Args& a, int vcu, int G) {
    bf16_t* ST = (bf16_t*)(a.ws + WS_XN);
    const float* decf = a.in[7]; const float* decb = a.in[8];
    const int gt = vcu * 512 + threadIdx.x, NT = G * 512;
    for (int s = gt; s < 131072; s += NT) {
        if (s < 65536) {
            const int dir = s >> 15, r = s & 32767, seq = r >> 12, eg = r & 4095, b = seq >> 2, h = seq & 3;
            const float lg = -__expf((dir ? decb : decf)[h]); const float cd = __expf(lg * 128.f);
            float s0 = 0.f, s1 = 0.f, s2 = 0.f, s3 = 0.f;
#pragma unroll 8
            for (int i = 0; i < 128; ++i) { const int n = dir ? 127 - i : i;
                u32x2* p = (u32x2*)(ST + ((size_t)dir * NUNITS_RET + (size_t)(b * 128 + n) * 4 + h) * 16384 + eg * 4);
                const u32x2 kv = *p; u32x2 o; o.x = pk2(s0, s1); o.y = pk2(s2, s3); *p = o;
                s0 = s0 * cd + bflo(kv.x); s1 = s1 * cd + bfhi(kv.x); s2 = s2 * cd + bflo(kv.y); s3 = s3 * cd + bfhi(kv.y); }
        } else {
#pragma unroll 1
            for (int rep = 0; rep < 2; ++rep) { const int it = (s - 65536) + rep * 65536;
                const int dir = it >> 16, r = it & 65535, seq = r >> 11, eg = r & 2047, b = seq >> 2, h = seq & 3;
                const float lg = -__expf((dir ? decb : decf)[h]); const float cd = __expf(lg * 128.f);
                float st[8];
#pragma unroll
                for (int k = 0; k < 8; ++k) st[k] = 0.f;
#pragma unroll 4
                for (int i = 0; i < 64; ++i) { const int n = dir ? 63 - i : i;
                    u32x4* p = (u32x4*)(ST + ((size_t)dir * NUNITS_RET + (size_t)(256 + b * 64 + n) * 4 + h) * 16384 + eg * 8);
                    const u32x4 kv = *p; u32x4 o; o.x = pk2(st[0], st[1]); o.y = pk2(st[2], st[3]); o.z = pk2(st[4], st[5]); o.w = pk2(st[6], st[7]); *p = o;
                    st[0] = st[0] * cd + bflo(kv.x); st[1] = st[1] * cd + bfhi(kv.x); st[2] = st[2] * cd + bflo(kv.y); st[3] = st[3] * cd + bfhi(kv.y);
                    st[4] = st[4] * cd + bflo(kv.z); st[5] = st[5] * cd + bfhi(kv.z); st[6] = st[6] * cd + bflo(kv.w); st[7] = st[7] * cd + bfhi(kv.w); } }
        }
    }
}
__device__ __forceinline__ void ret_out_unit(LAS unsigned char* L, bf16_t* PROJ, const bf16_t* ST, int u, const float* decf, const float* decb, const float* gnw) {
    const int tid = threadIdx.x, lane = tid & 63, wid = __builtin_amdgcn_readfirstlane(tid >> 6);
    const int cgk = u >> 2, h = u & 3; const size_t row0 = (size_t)cgk * 128;
    const float l2f = -__expf(decf[h]) * LOG2E, l2b = -__expf(decb[h]) * LOG2E;
    const bf16_t* Sf = ST + (size_t)u * 16384; const bf16_t* Sb = ST + ((size_t)NUNITS_RET + u) * 16384;
#pragma unroll 1
    for (int c = 0; c < 4; ++c) { const int idx = tid + 512 * c, row = idx >> 4, ch = idx & 15;
        *(LAS u32x4*)(L + 0 * RIMG + row * RP + ch * 16) = *(const u32x4*)(PROJ + (row0 + row) * PW + PC_K + 128 * h + 8 * ch);
        *(LAS u32x4*)(L + 1 * RIMG + row * RP + ch * 16) = *(const u32x4*)(PROJ + (row0 + row) * PW + PC_V + 128 * h + 8 * ch);
        *(LAS u32x4*)(L + 2 * RIMG + row * RP + ch * 16) = *(const u32x4*)(Sf + row * 128 + 8 * ch);
        *(LAS u32x4*)(L + 3 * RIMG + row * RP + ch * 16) = *(const u32x4*)(Sb + row * 128 + 8 * ch); }
    const int i16 = lane & 15, g = lane >> 4, ia = 16 * wid + i16;
    bf16x8 qf[4];
#pragma unroll
    for (int st = 0; st < 4; ++st) qf[st] = *(const bf16x8*)(PROJ + (row0 + ia) * PW + PC_Q + 128 * h + 32 * st + 8 * g);
    __syncthreads();
    const int tb = (i16 >> 2) * RP + 8 * (i16 & 3);
    pg8::f32x4 acc[8];
#pragma unroll
    for (int et = 0; et < 8; ++et) acc[et] = (pg8::f32x4){0.f, 0.f, 0.f, 0.f};
    const float qdf = __builtin_amdgcn_exp2f(l2f * (float)(ia + 1)), qdb = __builtin_amdgcn_exp2f(l2b * (float)(128 - ia));
    {
        const LAS unsigned char* SA = L + 2 * RIMG + tb + (8 * g) * RP;
#pragma unroll
        for (int et = 0; et < 8; ++et)
#pragma unroll
            for (int st = 0; st < 4; ++st) { const bf16x8 af = cat8(ldtr(SA + (32 * st) * RP + et * 32), ldtr(SA + (32 * st + 4) * RP + et * 32));
                acc[et] = __builtin_amdgcn_mfma_f32_16x16x32_bf16(af, qf[st], acc[et], 0, 0, 0); }
        const float ratio = qdf / qdb;
#pragma unroll
        for (int et = 0; et < 8; ++et) acc[et] = acc[et] * ratio;
    }
    {
        const LAS unsigned char* SA = L + 3 * RIMG + tb + (8 * g) * RP;
#pragma unroll
        for (int et = 0; et < 8; ++et)
#pragma unroll
            for (int st = 0; st < 4; ++st) { const bf16x8 af = cat8(ldtr(SA + (32 * st) * RP + et * 32), ldtr(SA + (32 * st + 4) * RP + et * 32));
                acc[et] = __builtin_amdgcn_mfma_f32_16x16x32_bf16(af, qf[st], acc[et], 0, 0, 0); }
#pragma unroll
        for (int et = 0; et < 8; ++et) acc[et] = acc[et] * qdb;
    }
    bf16x8 pf[4];
    {
        pg8::f32x4 sT[8];
        const LAS unsigned char* KA = L + i16 * RP + (8 * g) * 2;
#pragma unroll
        for (int jt = 0; jt < 8; ++jt) { sT[jt] = (pg8::f32x4){0.f, 0.f, 0.f, 0.f};
#pragma unroll
            for (int st = 0; st < 4; ++st) { const bf16x8 af = *(const LAS bf16x8*)(KA + (16 * jt) * RP + st * 64);
                sT[jt] = __builtin_amdgcn_mfma_f32_16x16x32_bf16(af, qf[st], sT[jt], 0, 0, 0); }
#pragma unroll
            for (int r = 0; r < 4; ++r) { const int j = 16 * jt + 4 * g + r, diff = ia - j;
                const float dv = diff >= 0 ? __builtin_amdgcn_exp2f(l2f * (float)diff) : __builtin_amdgcn_exp2f(l2b * (float)(-diff));
                sT[jt][r] *= dv; } }
#pragma unroll
        for (int s = 0; s < 4; ++s) { u32x4 w; w.x = pk2(sT[2 * s][0], sT[2 * s][1]); w.y = pk2(sT[2 * s][2], sT[2 * s][3]); w.z = pk2(sT[2 * s + 1][0], sT[2 * s + 1][1]); w.w = pk2(sT[2 * s + 1][2], sT[2 * s + 1][3]);
            pf[s] = __builtin_bit_cast(bf16x8, w); }
    }
    {
        const LAS unsigned char* VA = L + 1 * RIMG + tb + (4 * g) * RP;
#pragma unroll
        for (int et = 0; et < 8; ++et)
#pragma unroll
            for (int s = 0; s < 4; ++s) { const bf16x8 af = cat8(ldtr(VA + (32 * s) * RP + et * 32), ldtr(VA + (32 * s + 16) * RP + et * 32));
                acc[et] = __builtin_amdgcn_mfma_f32_16x16x32_bf16(af, pf[s], acc[et], 0, 0, 0); }
    }
    float sm = 0.f;
#pragma unroll
    for (int et = 0; et < 8; ++et) sm += (acc[et][0] + acc[et][1]) + (acc[et][2] + acc[et][3]);
    sm += __shfl_xor(sm, 16); sm += __shfl_xor(sm, 32);
    const float mu = sm * (1.f / 128.f); float vs = 0.f;
#pragma unroll
    for (int et = 0; et < 8; ++et) { acc[et] = acc[et] - mu; vs += (acc[et][0] * acc[et][0] + acc[et][1] * acc[et][1]) + (acc[et][2] * acc[et][2] + acc[et][3] * acc[et][3]); }
    vs += __shfl_xor(vs, 16); vs += __shfl_xor(vs, 32);
    const float rstd = __builtin_amdgcn_rsqf(vs * (1.f / 128.f) + 1e-5f);
    bf16_t* yrow = PROJ + (row0 + ia) * PW + PC_SG + 128 * h + 4 * g;
    const float* gw = gnw + 128 * h + 4 * g;
#pragma unroll
    for (int et = 0; et < 8; ++et) { const u32x2 sg = *(const u32x2*)(yrow + 16 * et); const f32x4 gn = *(const f32x4*)(gw + 16 * et);
        u32x2 o; o.x = pk2(acc[et][0] * rstd * gn[0] * bflo(sg.x), acc[et][1] * rstd * gn[1] * bfhi(sg.x)); o.y = pk2(acc[et][2] * rstd * gn[2] * bflo(sg.y), acc[et][3] * rstd * gn[3] * bfhi(sg.y));
        *(u32x2*)(yrow + 16 * et) = o; }
    __syncthreads();
}
__device__ __forceinline__ void phase_conv(const Args& a, int vcu, int G) {
    bf16_t* PROJ = (bf16_t*)(a.ws + WS_BIG); const float* cw = a.in[6];
    const int gt = vcu * 512 + threadIdx.x, NT = G * 512;
    for (int it = gt; it < T * 64; it += NT) {
        const int row = it >> 6, c8 = it & 63, pos = tok_pos(row), S = row < TP ? SP : SSQ;
        const bf16_t* up = PROJ + (size_t)row * PW + PC_U + 8 * c8;
        const u32x4 z = {0u, 0u, 0u, 0u};
        const u32x4 uc = *(const u32x4*)up, um = pos > 0 ? *(const u32x4*)(up - PW) : z, un = pos < S - 1 ? *(const u32x4*)(up + PW) : z;
        bf16_t* ap = PROJ + (size_t)row * PW + PC_AB + 8 * c8;
        const u32x4 ab = *(const u32x4*)ap;
        const f32x4 w0a = *(const f32x4*)(cw + 8 * c8), w0b = *(const f32x4*)(cw + 8 * c8 + 4), w1a = *(const f32x4*)(cw + 512 + 8 * c8), w1b = *(const f32x4*)(cw + 512 + 8 * c8 + 4),
                    w2a = *(const f32x4*)(cw + 1024 + 8 * c8), w2b = *(const f32x4*)(cw + 1024 + 8 * c8 + 4);
        u32x4 o;
#define CONV2(W, k0, k1, wa0, wa1, wb0, wb1, wc0, wc1) pk2(bflo(ab.W) * (wa0 * bflo(um.W) + wb0 * bflo(uc.W) + wc0 * bflo(un.W)), bfhi(ab.W) * (wa1 * bfhi(um.W) + wb1 * bfhi(uc.W) + wc1 * bfhi(un.W)))
        o.x = CONV2(x, 0, 1, w0a[0], w0a[1], w1a[0], w1a[1], w2a[0], w2a[1]);
        o.y = CONV2(y, 2, 3, w0a[2], w0a[3], w1a[2], w1a[3], w2a[2], w2a[3]);
        o.z = CONV2(z, 4, 5, w0b[0], w0b[1], w1b[0], w1b[1], w2b[0], w2b[1]);
        o.w = CONV2(w, 6, 7, w0b[2], w0b[3], w1b[2], w1b[3], w2b[2], w2b[3]);
#undef CONV2
        *(u32x4*)ap = o;
    }
}

constexpr int ASLOT = 16384, AXP = 132;
__device__ __forceinline__ int swz_f(int row) { return ((row & 3) << 2) | ((row >> 2) & 3); }
__device__ __forceinline__ void glds16(const void* sbase, unsigned voff, unsigned lds_dst) { unsigned keep;
    asm volatile("s_mov_b32 %0, m0\n\ts_mov_b32 m0, %3\n\ts_nop 0\n\tglobal_load_lds_dwordx4 %1, %2\n\ts_mov_b32 m0, %0" : "=&s"(keep) : "v"(voff), "s"(sbase), "s"(lds_dst) : "memory"); }
__device__ __forceinline__ void glds16x4(const void* k0, const void* k1, const void* v0, const void* v1, unsigned voff, unsigned lk0, unsigned lk1, unsigned lv0, unsigned lv1) { unsigned keep;
    asm volatile("s_mov_b32 %0, m0\n\t"
                 "s_mov_b32 m0, %6\n\ts_nop 0\n\tglobal_load_lds_dwordx4 %1, %2\n\t"
                 "s_mov_b32 m0, %7\n\ts_nop 0\n\tglobal_load_lds_dwordx4 %1, %3\n\t"
                 "s_mov_b32 m0, %8\n\ts_nop 0\n\tglobal_load_lds_dwordx4 %1, %4\n\t"
                 "s_mov_b32 m0, %9\n\ts_nop 0\n\tglobal_load_lds_dwordx4 %1, %5\n\t"
                 "s_mov_b32 m0, %0"
                 : "=&s"(keep) : "v"(voff), "s"(k0), "s"(k1), "s"(v0), "s"(v1), "s"(lk0), "s"(lk1), "s"(lv0), "s"(lv1) : "memory"); }
__device__ __forceinline__ float rowmax32(const f32x16& a, const f32x16& b) {
    float m0 = fmaxf(fmaxf(a[0], a[1]), b[0]), m1 = fmaxf(fmaxf(a[2], a[3]), b[1]);
    m0 = fmaxf(fmaxf(m0, b[2]), b[3]);
#pragma unroll
    for (int r = 4; r < 16; r += 4) { m0 = fmaxf(fmaxf(m0, a[r]), a[r + 1]); m1 = fmaxf(fmaxf(m1, a[r + 2]), a[r + 3]); m0 = fmaxf(fmaxf(m0, b[r]), b[r + 1]); m1 = fmaxf(fmaxf(m1, b[r + 2]), b[r + 3]); }
    const float m = fmaxf(m0, m1);
    auto rr = __builtin_amdgcn_permlane32_swap(__float_as_uint(m), __float_as_uint(m), false, false);
    return fmaxf(__uint_as_float(rr[0]), __uint_as_float(rr[1]));
}
#define ASB() __builtin_amdgcn_sched_barrier(0)
__device__ __forceinline__ void attn_unit(LAS unsigned char* L, bf16_t* QKV, size_t rowbase, int S, int h, int qb, float lam, const float* subln, unsigned* kmax) {
    const int tid = threadIdx.x, lane = tid & 63, wid = __builtin_amdgcn_readfirstlane(tid >> 6);
    const int r32 = lane & 31, hi = lane >> 5, qblk = wid & 3, hd = wid >> 2;
    const int li = lane & 15, dsub = (lane >> 4) & 1, q_ = li >> 2, p_ = li & 3;
    const size_t qrow = rowbase + (size_t)qb * 128 + qblk * 32 + r32;
    bf16x8 qf[4];
#pragma unroll
    for (int st = 0; st < 4; ++st) qf[st] = *(const bf16x8*)(QKV + qrow * 1024 + 128 * h + 64 * hd + 16 * st + 8 * hi);
    const int drow = lane >> 4, dch = (lane & 15) ^ ((drow << 2) | (wid & 3));
    const bf16_t* const kbase = QKV + (size_t)T * 1024 + ((size_t)h * T + rowbase) * 256;
    const unsigned kgo = (unsigned)(((4 * wid + drow) * 256 + 8 * dch) * 2);
    const unsigned l0 = (unsigned)(uintptr_t)L;
    const unsigned dK = (unsigned)__builtin_amdgcn_readfirstlane((int)(l0 + wid * 1024)), dV = dK + 4 * ASLOT;
#define DMA_K(t, slot) do { const bf16_t* p_ = kbase + (size_t)(64 * (t)) * 256; glds16(p_, kgo, dK + (slot) * ASLOT); glds16(p_ + (size_t)32 * 256, kgo, dK + (slot) * ASLOT + 8192); } while (0)
#define DMA_V(t, slot) do { const bf16_t* p_ = kbase + (size_t)(64 * (t)) * 256 + 128; glds16(p_, kgo, dV + (slot) * ASLOT); glds16(p_ + (size_t)32 * 256, kgo, dV + (slot) * ASLOT + 8192); } while (0)
#define DMA_WAIT_BAR() do { asm volatile("s_waitcnt vmcnt(0)" ::: "memory"); __syncthreads(); } while (0)
#define DMA_WAIT8_BAR() do { asm volatile("s_waitcnt vmcnt(8)" ::: "memory"); __syncthreads(); } while (0)
    const int kb0 = 256 * r32 + 16 * ((8 * hd + hi) ^ swz_f(r32));
    const int vb0 = 4 * ASLOT + 256 * (4 * hi + q_) + 16 * ((2 * dsub + (p_ >> 1)) ^ ((q_ << 2) | hi)) + 8 * (p_ & 1);
    const int NT = S / 64;
    DMA_K(0, 0); DMA_K(1, 1); DMA_V(0, 0); DMA_K(2, 2); DMA_V(1, 1); DMA_K(3, 3); DMA_V(2, 2);
    f32x16 o[4], negm; float lsum = 0.f, lsb = 0.f, lsc = 0.f, lsd = 0.f;
#pragma unroll
    for (int d = 0; d < 4; ++d) o[d] = (f32x16){};
    {
        const int seq = rowbase < (size_t)TP ? (int)(rowbase >> 14) : 2 + (int)((rowbase - TP) >> 13);
        unsigned* kp = kmax + (seq * 16 + 2 * h + hd) * 2;
        const float kb = sqrtf(__uint_as_float(__hip_atomic_load(kp, __ATOMIC_RELAXED, __HIP_MEMORY_SCOPE_AGENT)) + __uint_as_float(__hip_atomic_load(kp + 1, __ATOMIC_RELAXED, __HIP_MEMORY_SCOPE_AGENT)));
        float q2 = 0.f;
#pragma unroll
        for (int st = 0; st < 4; ++st) { const u32x4 w = __builtin_bit_cast(u32x4, qf[st]);
            q2 += ((bflo(w.x) * bflo(w.x) + bfhi(w.x) * bfhi(w.x)) + (bflo(w.y) * bflo(w.y) + bfhi(w.y) * bfhi(w.y))) + ((bflo(w.z) * bflo(w.z) + bfhi(w.z) * bfhi(w.z)) + (bflo(w.w) * bflo(w.w) + bfhi(w.w) * bfhi(w.w))); }
        q2 += __shfl_xor(q2, 32);
        const float mref = sqrtf(q2) * kb;
#pragma unroll
        for (int r = 0; r < 16; ++r) negm[r] = -mref; }
    DMA_WAIT_BAR();
    bf16x8 kf[8], va[4], vb[4];
#define RD_K(slot) do { const LAS unsigned char* kp_ = L + (slot) * ASLOT; \
        _Pragma("unroll") for (int st = 0; st < 4; ++st) { kf[2 * st] = *(const LAS bf16x8*)(kp_ + (kb0 ^ (32 * st))); kf[2 * st + 1] = *(const LAS bf16x8*)(kp_ + 8192 + (kb0 ^ (32 * st))); } } while (0)
#define RD_V(dst, slot, s) do { const LAS unsigned char* vp_ = L + (slot) * ASLOT; \
        _Pragma("unroll") for (int d = 0; d < 4; ++d) dst[d] = cat8(ldtr(vp_ + (vb0 ^ (64 * d)) + 4096 * (s)), ldtr(vp_ + ((vb0 ^ (64 * d)) ^ 32) + 4096 * (s) + 2048)); } while (0)
#define PV5(src, pfs) do { _Pragma("unroll") for (int d = 0; d < 4; ++d) o[d] = __builtin_amdgcn_mfma_f32_32x32x16_bf16(src[d], pfs, o[d], 0, 0, 0); } while (0)
    RD_K(0);
    __syncthreads();
    bf16x8 pf[4];
#define EXPQ(SV, B, DST) do { \
        _Pragma("unroll") for (int r = 0; r < 8; ++r) SV[(B) + r] = __builtin_amdgcn_exp2f(SV[(B) + r]); \
        _Pragma("unroll") for (int r = 0; r < 8; r += 4) { asm("v_add_f32_e32 %0, %1, %0" : "+v"(lsum) : "v"(SV[(B) + r])); asm("v_add_f32_e32 %0, %1, %0" : "+v"(lsb) : "v"(SV[(B) + r + 1])); asm("v_add_f32_e32 %0, %1, %0" : "+v"(lsc) : "v"(SV[(B) + r + 2])); asm("v_add_f32_e32 %0, %1, %0" : "+v"(lsd) : "v"(SV[(B) + r + 3])); }     \
        u32x4 w_; w_.x = pk2(SV[(B)], SV[(B) + 1]); w_.y = pk2(SV[(B) + 2], SV[(B) + 3]); w_.z = pk2(SV[(B) + 4], SV[(B) + 5]); w_.w = pk2(SV[(B) + 6], SV[(B) + 7]); DST = __builtin_bit_cast(bf16x8, w_); } while (0)
#define MIX4() do { _Pragma("unroll") for (int i_ = 0; i_ < 4; ++i_) { __builtin_amdgcn_sched_group_barrier(0x008, 1, 0); __builtin_amdgcn_sched_group_barrier(0x002, 5, 0); } } while (0)
#define TILE(tt, SL) do { \
        { const int tk = ((tt) + 4 < NT) ? (tt) + 4 : NT - 1, tv = ((tt) + 3 < NT) ? (tt) + 3 : NT - 1;     \
          const bf16_t* pk_ = kbase + (size_t)(64 * tk) * 256; const bf16_t* pv_ = kbase + (size_t)(64 * tv) * 256 + 128; \
          glds16x4(pk_, pk_ + (size_t)32 * 256, pv_, pv_ + (size_t)32 * 256, kgo, dK + (SL) * ASLOT, dK + (SL) * ASLOT + 8192, dV + (((SL) + 3) & 3) * ASLOT, dV + (((SL) + 3) & 3) * ASLOT + 8192); } \
        ASB(); \
        f32x16 s0 = __builtin_amdgcn_mfma_f32_32x32x16_bf16(kf[0], qf[0], negm, 0, 0, 0);     \
        _Pragma("unroll") for (int st = 1; st < 4; ++st) s0 = __builtin_amdgcn_mfma_f32_32x32x16_bf16(kf[2 * st], qf[st], s0, 0, 0, 0); \
        ASB(); \
        RD_V(va, SL, 0); RD_V(vb, SL, 1); \
        ASB(); \
        f32x16 s1 = __builtin_amdgcn_mfma_f32_32x32x16_bf16(kf[1], qf[0], negm, 0, 0, 0); \
        _Pragma("unroll") for (int st = 1; st < 4; ++st) s1 = __builtin_amdgcn_mfma_f32_32x32x16_bf16(kf[2 * st + 1], qf[st], s1, 0, 0, 0); \
        EXPQ(s0, 0, pf[0]); MIX4(); \
        ASB(); \
        PV5(va, pf[0]); EXPQ(s0, 8, pf[1]); MIX4(); \
        ASB(); \
        RD_V(va, SL, 2); \
        PV5(vb, pf[1]); EXPQ(s1, 0, pf[2]); MIX4(); \
        ASB(); \
        RD_V(vb, SL, 3); \
        PV5(va, pf[2]); EXPQ(s1, 8, pf[3]); MIX4(); \
        ASB(); \
        RD_K(((SL) + 1) & 3);     \
        PV5(vb, pf[3]); \
        ASB(); \
        DMA_WAIT8_BAR(); } while (0)
    for (int t = 0; t < NT; t += 4) { TILE(t, 0); TILE(t + 1, 1); TILE(t + 2, 2); TILE(t + 3, 3); }
#undef TILE
#undef EXPQ
#undef MIX4
    DMA_WAIT_BAR();
#undef DMA_K
#undef DMA_V
#undef DMA_WAIT_BAR
#undef DMA_WAIT8_BAR
#undef RD_K
#undef RD_V
#undef PV5
    lsum = (lsum + lsb) + (lsc + lsd);
    const float inv = 1.f / (lsum + __shfl_xor(lsum, 32));
    LAS float* X = (LAS float*)L;
    const int xo = (32 * qblk + r32) * AXP + 4 * hi;
    if (hd == 1) { const float sc = inv * lam;
#pragma unroll
        for (int d = 0; d < 4; ++d)
#pragma unroll
            for (int rg = 0; rg < 4; ++rg) *(LAS f32x4*)(X + xo + 32 * d + 8 * rg) = (f32x4){o[d][4 * rg] * sc, o[d][4 * rg + 1] * sc, o[d][4 * rg + 2] * sc, o[d][4 * rg + 3] * sc}; }
    __syncthreads();
    if (hd == 0) { float ss = 0.f;
#pragma unroll
        for (int d = 0; d < 4; ++d)
#pragma unroll
            for (int rg = 0; rg < 4; ++rg) { const f32x4 x = *(const LAS f32x4*)(X + xo + 32 * d + 8 * rg);
#pragma unroll
                for (int k = 0; k < 4; ++k) { const float v = o[d][4 * rg + k] * inv - x[k]; o[d][4 * rg + k] = v; ss += v * v; } }
        ss += __shfl_xor(ss, 32);
        const float rms = __builtin_amdgcn_rsqf(ss * (1.f / 128.f) + 1e-5f) * (1.f - LAMBDA_INIT);
        bf16_t* orow = QKV + qrow * 1024 + 128 * h + 4 * hi;
#pragma unroll
        for (int d = 0; d < 4; ++d)
#pragma unroll
            for (int rg = 0; rg < 4; ++rg) { const f32x4 w = *(const f32x4*)(subln + 32 * d + 8 * rg + 4 * hi);
                u32x2 ov; ov.x = pk2(o[d][4 * rg] * rms * w[0], o[d][4 * rg + 1] * rms * w[1]); ov.y = pk2(o[d][4 * rg + 2] * rms * w[2], o[d][4 * rg + 3] * rms * w[3]);
                *(u32x2*)(orow + 32 * d + 8 * rg) = ov; } }
    __syncthreads();
}

#define XB_TMO      128
#define XB_XCNT(j)  (256  + 64 * (j))
#define XB_XSUB(j)  (1280 + 64 * (j))
#define XB_XGEN(j)  (2304 + 64 * (j))
#define XB_TOP      3328
#define XB_TOPGEN   3392
#define XCD_BAR_WORDS 3456
#define XB_SPIN_CAP (1u << 18)

__device__ __forceinline__ unsigned xb_ld(unsigned* p)              { return __hip_atomic_load(p, __ATOMIC_RELAXED, __HIP_MEMORY_SCOPE_AGENT); }
__device__ __forceinline__ unsigned xb_add(unsigned* p, unsigned v) { return __hip_atomic_fetch_add(p, v, __ATOMIC_RELAXED, __HIP_MEMORY_SCOPE_AGENT); }
__device__ __forceinline__ unsigned xb_xcc_id() { return (unsigned)__builtin_amdgcn_s_getreg((3 << 11) | 20) & 0xFu; }
#define XB_SPIN(cond, bar) do { unsigned _sp = 0; while (cond) { __builtin_amdgcn_s_sleep(1); \
    if ((++_sp & 255u) == 0u) { if (xb_ld(&(bar)[XB_TMO])) break; if (_sp > XB_SPIN_CAP) { atomicAdd(&(bar)[XB_TMO], 1u); break; } } } } while (0)

struct XcdBarrier {
    unsigned* bar; unsigned x;
    volatile LAS unsigned* st;
};

__device__ __forceinline__ XcdBarrier xcd_barrier_post(unsigned* bar, volatile LAS unsigned* st) {
    XcdBarrier b; b.bar = bar; b.x = xb_xcc_id(); b.st = st;
    if (threadIdx.x == 0) (void)xb_add(&bar[XB_XCNT(b.x)], 1u);
    return b;
}
__device__ __forceinline__ void xcd_barrier_complete(unsigned* bar, unsigned x, unsigned& nloc, unsigned& nx) {
    const unsigned G = gridDim.x * gridDim.y * gridDim.z;
    unsigned sum, cnt, mine, sp = 0u;
    for (;;) {
        sum = 0u; cnt = 0u; mine = 0u;
#pragma unroll
        for (unsigned j = 0; j < 16; ++j) { const unsigned c = xb_ld(&bar[XB_XCNT(j)]); sum += c; cnt += (c > 0u) ? 1u : 0u; mine = (j == x) ? c : mine; }
        if (sum == G) break;
        __builtin_amdgcn_s_sleep(1);
        if ((++sp & 255u) == 0u) { if (xb_ld(&bar[XB_TMO])) break; if (sp > XB_SPIN_CAP) { atomicAdd(&bar[XB_TMO], 1u); break; } }
    }
    nloc = mine > 0u ? mine : 1u; nx = cnt > 0u ? cnt : 1u;
}

__device__ __forceinline__ void xcd_barrier(const XcdBarrier& b) {
    asm volatile("s_waitcnt vmcnt(0)" ::: "memory");
    __syncthreads();
    if (threadIdx.x == 0) {
        unsigned* bar = b.bar;
        __builtin_amdgcn_s_waitcnt(0);
        unsigned nloc = b.st[0], nx = b.st[1];
        if (nloc == 0u) { xcd_barrier_complete(bar, b.x, nloc, nx); b.st[0] = nloc; b.st[1] = nx; }
        const unsigned old = xb_add(&bar[XB_XSUB(b.x)], 1u);
        const unsigned gen = old / nloc;
        if (old + 1u == (gen + 1u) * nloc) {
            __builtin_amdgcn_fence(__ATOMIC_RELEASE, "agent");
            asm volatile("s_waitcnt vmcnt(0)" ::: "memory");
            const unsigned og = xb_add(&bar[XB_TOP], 1u);
            const unsigned tg = og / nx;
            if (og + 1u == (tg + 1u) * nx) xb_add(&bar[XB_TOPGEN], 1u);
            else XB_SPIN(xb_ld(&bar[XB_TOPGEN]) == tg, bar);
            __builtin_amdgcn_fence(__ATOMIC_ACQUIRE, "agent");
            xb_add(&bar[XB_XGEN(b.x)], 1u);
            asm volatile("s_waitcnt vmcnt(0)" ::: "memory");
        } else {
            XB_SPIN(xb_ld(&bar[XB_XGEN(b.x)]) == gen, bar);
            __builtin_amdgcn_fence(__ATOMIC_ACQUIRE, "agent");
            asm volatile("s_waitcnt vmcnt(0)" ::: "memory");
        }
    }
    __syncthreads();
}

__global__ void __launch_bounds__(512, 2) mk_fwd(Args args) {
    extern __shared__ __attribute__((aligned(16))) unsigned char lds[];
    LAS unsigned char* L = (LAS unsigned char*)lds;
    const int G = gridDim.x, bx = blockIdx.x;
    const int vcu = (G % 8 == 0) ? (bx % 8) * (G / 8) + bx / 8 : bx;
    unsigned char* ws = args.ws;
    const int lo = args.ph_lo, hi = args.ph_hi;
    bf16_t* XN = (bf16_t*)(ws + WS_XN); bf16_t* BIG = (bf16_t*)(ws + WS_BIG); float* PART = (float*)(ws + WS_PART);
    float* out = args.out;
#define IN(k) (lo <= (k) && (k) < hi)
    volatile LAS unsigned* bst = (volatile LAS unsigned*)(L + 147968);
    if (threadIdx.x < 2) bst[threadIdx.x] = 0u;
    __syncthreads();
    XcdBarrier xbar; xbar.bar = (unsigned*)ws; xbar.x = 0; xbar.st = nullptr;
    if (args.coop) xbar = xcd_barrier_post((unsigned*)ws, bst);
#define SEAM(k) do { if (IN(k) && IN((k) + 1)) { if (args.coop) { if ((k) == 0) cg::this_grid().sync(); else xcd_barrier(xbar); } } } while (0)
    if (IN(0)) { phase_prologue(args, L, vcu, G); __syncthreads(); }
    SEAM(0);
    if (IN(1)) {
        pg8::Gemm g{XN, (const bf16_t*)(ws + WS_WIN), T, NIN, DM, DM}; pg8::StaticOrder S; S.init(T, NIN, G, bx);
        EpiInProj E{BIG, (const float*)(ws + WS_TAB128)};
        pg8::gemm_phase<EpiInProj, pg8::StaticOrder, true, true>(L, g, S, E);
    }
    SEAM(1);
    if (IN(2)) { for (int u = vcu; u < NUNITS_RET; u += G) ret_kv_unit(L, BIG, XN, u, args.in[7], args.in[8]); }
    SEAM(2);
    if (IN(3)) phase_scan(args, vcu, G);
    SEAM(3);
    if (IN(4)) { phase_conv(args, vcu, G); for (int u = vcu; u < NUNITS_RET; u += G) ret_out_unit(L, BIG, XN, u, args.in[7], args.in[8], args.in[9]); }
    SEAM(4);
    if (IN(5)) {
        pg8::Gemm g{BIG, (const bf16_t*)(ws + WS_WOUT0), T, DM, DM, PW}; pg8::StaticOrder S; S.init(T, DM, G, bx);
        EpiRes<true> E{args.in[0], args.in[1] - (size_t)TP * DM, XN, PART};
        pg8::gemm_phase<EpiRes<true>, pg8::StaticOrder, true, true>(L, g, S, E);
    }
    SEAM(5);
    if (IN(6)) {
        pg8::Gemm g{XN, (const bf16_t*)(ws + WS_WGU0), T, NGU, DM, DM}; pg8::StaticOrder S; S.init(T, NGU, G, bx);
        EpiGU E{BIG, PART};
        pg8::gemm_phase<EpiGU, pg8::StaticOrder, true, true>(L, g, S, E);
    }
    SEAM(6);
    if (IN(7)) {
        pg8::Gemm g{BIG, (const bf16_t*)(ws + WS_WD0), T, DM, DFF, DFF}; pg8::StaticOrder S; S.init(T, DM, G, bx);
        EpiRes<false> E{nullptr, nullptr, XN, PART};
        pg8::gemm_phase<EpiRes<false>, pg8::StaticOrder, true, true>(L, g, S, E);
    }
    SEAM(7);
    if (IN(8)) {
        pg8::Gemm g{XN, (const bf16_t*)(ws + WS_WQKV), T, NQKV, DM, DM}; pg8::StaticOrder S; S.init(T, NQKV, G, bx);
        EpiQKV E{BIG, (const float*)(ws + WS_TAB64), PART, (unsigned*)ws + 3584};
        pg8::gemm_phase<EpiQKV, pg8::StaticOrder, true, true>(L, g, S, E);
    }
    SEAM(8);
    if (IN(9)) {
        float d1 = 0.f, d2 = 0.f;
        for (int i = 0; i < 64; ++i) { d1 += args.in[12][i] * args.in[13][i]; d2 += args.in[14][i] * args.in[15][i]; }
        const float lam = __expf(d1) - __expf(d2) + LAMBDA_INIT;
        const int per = (6144 + G - 1) / G;
        for (int w = vcu * per; w < (vcu + 1) * per && w < 6144; ++w) {
            const int xcd = w / 768, rem = w % 768, j = rem / 24, i = rem % 24;
            size_t rowbase; int S, h, qb;
            if (i < 8) { const int pair = 2 * xcd + (i >> 2); rowbase = (size_t)(pair >> 3) * SP; S = SP; h = pair & 7; qb = (i & 3) * 32 + j; }
            else { const int i2 = i - 8, pair = 8 * xcd + (i2 >> 1); rowbase = (size_t)TP + (size_t)(pair >> 3) * SSQ; S = SSQ; h = pair & 7; qb = (i2 & 1) * 32 + j; }
            attn_unit(L, BIG, rowbase, S, h, qb, lam, args.in[16], (unsigned*)ws + 3584);
        }
    }
    SEAM(9);
    if (IN(10)) {
        pg8::Gemm g{BIG, (const bf16_t*)(ws + WS_WO1), T, DM, DM, DM}; pg8::StaticOrder S; S.init(T, DM, G, bx);
        EpiRes<false> E{nullptr, nullptr, XN, PART};
        pg8::gemm_phase<EpiRes<false>, pg8::StaticOrder, true, true>(L, g, S, E);
    }
    SEAM(10);
    if (IN(11)) {
        pg8::Gemm g{XN, (const bf16_t*)(ws + WS_WGU1), T, NGU, DM, DM}; pg8::StaticOrder S; S.init(T, NGU, G, bx);
        EpiGU E{BIG, PART};
        pg8::gemm_phase<EpiGU, pg8::StaticOrder, true, true>(L, g, S, E);
    }
    SEAM(11);
    if (IN(12)) {
        pg8::Gemm g{BIG, (const bf16_t*)(ws + WS_WD1), T, DM, DFF, DFF}; pg8::StaticOrder S; S.init(T, DM, G, bx);
        EpiRes<false> E{nullptr, nullptr, XN, PART};
        pg8::gemm_phase<EpiRes<false>, pg8::StaticOrder, true, true>(L, g, S, E);
    }
    SEAM(12);
    if (IN(13)) {
        const int lane = threadIdx.x & 63, wave = threadIdx.x >> 6, gw = vcu * 8 + wave, NGW = G * 8;
        f32x4 w[4];
#pragma unroll
        for (int j = 0; j < 2; ++j) { w[2 * j] = ((const f32x4*)args.in[4])[2 * (lane + 64 * j)]; w[2 * j + 1] = ((const f32x4*)args.in[4])[2 * (lane + 64 * j) + 1]; }
        for (int m = gw; m < T; m += NGW) {
            const float rs = row_scale(PART, m);
            const u32x4* xr = (const u32x4*)(XN + (size_t)m * DM); f32x4* yr = (f32x4*)(out + (size_t)m * DM);
#pragma unroll
            for (int j = 0; j < 2; ++j) { const u32x4 v = xr[lane + 64 * j];
                yr[2 * (lane + 64 * j)] = (f32x4){bflo(v.x), bfhi(v.x), bflo(v.y), bfhi(v.y)} * rs * w[2 * j];
                yr[2 * (lane + 64 * j) + 1] = (f32x4){bflo(v.z), bfhi(v.z), bflo(v.w), bfhi(v.w)} * rs * w[2 * j + 1]; }
        }
    }
#undef IN
#undef SEAM
}

extern "C" void kernel_launch(void* const* d_in, const int* in_sizes, int n_in, void* d_out, int out_size, void* d_ws, size_t ws_size, hipStream_t stream) {
    static int grid = 0;
    if (grid == 0) {
        if (n_in != 21 || out_size != T * DM || ws_size < WS_END) { fprintf(stderr, "kernel_launch: unexpected shapes: n_in %d out %d ws %zu (need %zu)\n", n_in, out_size, ws_size, (size_t)WS_END); grid = -1; return; }
        int dev = 0, cus = 0, per_cu = 0;
        hipGetDevice(&dev); hipDeviceGetAttribute(&cus, hipDeviceAttributeMultiprocessorCount, dev);
        if (hipFuncSetAttribute((const void*)mk_fwd, hipFuncAttributeMaxDynamicSharedMemorySize, LDS_BYTES) != hipSuccess) { fprintf(stderr, "kernel_launch: hipFuncSetAttribute failed\n"); grid = -1; return; }
        if (hipOccupancyMaxActiveBlocksPerMultiprocessor(&per_cu, (const void*)mk_fwd, 512, LDS_BYTES) != hipSuccess || per_cu < 1) { fprintf(stderr, "kernel_launch: occupancy query says %d\n", per_cu); per_cu = 1; }
        (void)hipGetLastError();
        grid = cus * 1;
    }
    if (grid < 0) return;
    if (hipMemsetAsync(d_ws, 0, 16384, stream) != hipSuccess) { fprintf(stderr, "kernel_launch: hipMemsetAsync failed\n"); return; }
    Args a{};
    for (int i = 0; i < 21; ++i) a.in[i] = (const float*)d_in[i];
    a.out = (float*)d_out; a.ws = (unsigned char*)d_ws;
#if MK_MULTI
    for (int p = 0; p < 14; ++p) { a.ph_lo = p; a.ph_hi = p + 1; a.coop = 0; hipLaunchKernelGGL(mk_fwd, dim3(grid), dim3(512), LDS_BYTES, stream, a); }
#else
    a.ph_lo = 0; a.ph_hi = 14; a.coop = 1;
    void* kargs[] = {&a};
    hipError_t e = hipLaunchCooperativeKernel((const void*)mk_fwd, dim3(grid), dim3(512), kargs, LDS_BYTES, stream);
    if (e != hipSuccess) fprintf(stderr, "cooperative launch failed: %s (grid %d)\n", hipGetErrorString(e), grid);
#endif
}
```

```cpp
#include <hip/hip_runtime.h>
#include <hip/hip_cooperative_groups.h>
#include <cstdio>
#include <cstdint>
namespace cg = cooperative_groups;
#ifndef MK_MULTI
#define MK_MULTI 0
#endif
namespace pg8 {
#define PG8_LAS __attribute__((address_space(3)))
typedef unsigned short bf16_t;
typedef short bf16x8 __attribute__((ext_vector_type(8)));
typedef float f32x4 __attribute__((ext_vector_type(4)));
typedef unsigned u32x4 __attribute__((ext_vector_type(4)));
constexpr int BM = 256, BK = 64, HALF = 128, HTB = HALF * BK * 2  , STAGE_BYTES = 8 * HTB, NXCD = 8, WGM = 8;

__host__ __device__ __forceinline__ int lds_byte(int r, int c) { const int st = (r >> 4) * 2 + (c >> 5), rr = r & 15, cc = c & 31, ob = rr * 64 + cc * 2; return st * 1024 + (ob ^ (((ob >> 9) & 1) << 5)); }
__host__ __device__ __forceinline__ void stage_rc(int b, int& R, int& C) { const int st = b / 1024, sb = b % 1024, swz = sb ^ (((sb >> 9) & 1) << 5); R = (st >> 1) * 16 + swz / 64; C = (st & 1) * 32 + (swz % 64) / 2; }
__host__ __device__ __forceinline__ int perm32(int rho) { const int n = rho >> 4, i = rho & 15; return 8 * (i >> 2) + 4 * n + (i & 3); }

struct Unit { int pm, pn; };
struct Gemm { const bf16_t* A; const bf16_t* Bt; int M, N, K, lda; };

struct StaticOrder {
    int nM, nN, nwg, G, c;
    __host__ __device__ void init(int M, int N, int G_, int c_) { nM = M / BM; nN = N / BM; nwg = nM * nN; G = G_; c = c_; }
    __host__ __device__ bool next(int i, Unit& u) const {
        const long L = (long)i * G + c; if (L >= nwg) return false;
        int wgid = (int)L; { const int q = nwg / NXCD, r = nwg % NXCD, xcd = wgid % NXCD, off = wgid / NXCD; wgid = (xcd < r ? xcd * (q + 1) : r * (q + 1) + (xcd - r) * q) + off; }
        const int nig = WGM * nN, gid = wgid / nig, fm = gid * WGM, gsz = (nM - fm) < WGM ? (nM - fm) : WGM;
        u.pm = fm + ((wgid % nig) % gsz); u.pn = (wgid % nig) / gsz; return true;
    }
    __device__ __forceinline__ void a_ready(const Unit&) const {}
    __device__ __forceinline__ void done(const Unit&) const {}
};

template <class Epi, class Sched, bool ALIGN_EPI = false, bool SP2 = false>
__device__ __forceinline__ void gemm_phase(PG8_LAS unsigned char* lds, const Gemm g, const Sched& S, const Epi& E) {
    const int tid = threadIdx.x, wid = __builtin_amdgcn_readfirstlane(tid >> 6), lane = tid & 63, wr = wid >> 2, wc = wid & 3, fr = lane & 15, fq = lane >> 4;
    const int K = g.K, nt = K / BK, lda = g.lda;
    unsigned voffA[2], voffB[2];
#pragma unroll
    for (int i = 0; i < 2; ++i) { int R, C; stage_rc(tid * 16 + i * 8192, R, C); const int Rb = Epi::PERM ? ((R & ~31) + perm32(R & 31)) : R;
        voffA[i] = (unsigned)(R * lda + C) * 2u; voffB[i] = (unsigned)(Rb * K + C) * 2u; }
    const size_t kstep = (size_t)(BK * 2);
    const size_t hstep = (size_t)HALF * K * 2;
    const size_t tstep = 2 * hstep; const size_t hstepA = (size_t)HALF * lda * 2, tstepA = 2 * hstepA;
    const unsigned ldsw = (unsigned)wid * 1024u;
    const int aoff = lds_byte(wr * 64 + fr, fq * 8), boff = lds_byte(wc * 32 + fr, fq * 8);
#define PG8_SA(b, h) (((b) * 2 + (h)) * HTB)
#define PG8_SB(b, h) ((4 + (b) * 2 + (h)) * HTB)
#define PG8_STAGE(bufoff, gbase, voff) do { _Pragma("unroll") for (int _i = 0; _i < 2; ++_i) \
        __builtin_amdgcn_global_load_lds((const unsigned*)((const char*)(gbase) + (voff)[_i]), (PG8_LAS unsigned*)(lds + (bufoff) + ldsw + _i * 8192), 16, 0, 0); } while (0)
#define PG8_LDA(dst, b, h) do { _Pragma("unroll") for (int m = 0; m < 4; ++m) _Pragma("unroll") for (int k = 0; k < 2; ++k) dst[m][k] = *(const PG8_LAS bf16x8*)(lds + PG8_SA(b, h) + aoff + m * 2048 + k * 1024); } while (0)
#define PG8_LDB(dst, b, h) do { _Pragma("unroll") for (int n = 0; n < 2; ++n) _Pragma("unroll") for (int k = 0; k < 2; ++k) dst[n][k] = *(const PG8_LAS bf16x8*)(lds + PG8_SB(b, h) + boff + n * 2048 + k * 1024); } while (0)
#define PG8_MMA(ai, bj, At, Bt) do { __builtin_amdgcn_s_setprio(1); _Pragma("unroll") for (int m = 0; m < 4; ++m) _Pragma("unroll") for (int n = 0; n < 2; ++n) _Pragma("unroll") for (int k = 0; k < 2; ++k) \
        acc[ai][bj][m][n] = __builtin_amdgcn_mfma_f32_16x16x32_bf16(Bt[n][k], At[m][k], acc[ai][bj][m][n], 0, 0, 0); __builtin_amdgcn_s_setprio(0); } while (0)
#define PG8_WAIT_V(n) asm volatile("s_waitcnt vmcnt(" #n ")" ::: "memory")
#define PG8_WAIT_L(n) asm volatile("s_waitcnt lgkmcnt(" #n ")" ::: "memory")
#define PG8_BAR __builtin_amdgcn_s_barrier()
#define PG8_SCHED __builtin_amdgcn_sched_barrier(0)
    Unit cur, nxt; int ui = 0;
    if (!S.next(0, cur)) return;
    f32x4 acc[2][2][4][2];
#pragma unroll
    for (int a = 0; a < 2; ++a)
#pragma unroll
        for (int b = 0; b < 2; ++b)
#pragma unroll
            for (int m = 0; m < 4; ++m)
#pragma unroll
                for (int n = 0; n < 2; ++n) acc[a][b][m][n] = (f32x4){0.f, 0.f, 0.f, 0.f};
    bf16x8 At[4][2], B0[2][2], B1[2][2];
    const char* cA = (const char*)g.A + (size_t)cur.pm * tstepA; const char* cB = (const char*)g.Bt + (size_t)cur.pn * tstep;
    S.a_ready(cur);
    if constexpr (SP2) {
        PG8_STAGE(PG8_SB(0, 0), cB, voffB); PG8_STAGE(PG8_SB(0, 1), cB + hstep, voffB); PG8_STAGE(PG8_SA(0, 0), cA, voffA); PG8_STAGE(PG8_SA(0, 1), cA + hstepA, voffA);
        if (wr == 1) PG8_BAR;
        PG8_WAIT_V(2); PG8_BAR;
        PG8_STAGE(PG8_SB(1, 0), cB + kstep, voffB); PG8_STAGE(PG8_SA(1, 0), cA + kstep, voffA); PG8_STAGE(PG8_SB(1, 1), cB + hstep + kstep, voffB);
        PG8_WAIT_V(6); PG8_BAR;
    } else {
        PG8_STAGE(PG8_SB(0, 0), cB, voffB); PG8_STAGE(PG8_SA(0, 0), cA, voffA); PG8_STAGE(PG8_SB(0, 1), cB + hstep, voffB); PG8_STAGE(PG8_SA(0, 1), cA + hstepA, voffA);
        if (wr == 1) PG8_BAR;
        PG8_WAIT_V(4); PG8_BAR;
        PG8_STAGE(PG8_SB(1, 0), cB + kstep, voffB); PG8_STAGE(PG8_SA(1, 0), cA + kstep, voffA); PG8_STAGE(PG8_SB(1, 1), cB + hstep + kstep, voffB);
        PG8_WAIT_V(6); PG8_BAR;
    }
    for (;;) {
        const bool has_next = S.next(ui + 1, nxt);
        const char* nA = has_next ? (const char*)g.A + (size_t)nxt.pm * tstepA : cA; const char* nB = has_next ? (const char*)g.Bt + (size_t)nxt.pn * tstep : cB;
        for (int t = 0; t < nt; t += 2) {
            const bool last = (t == nt - 2);
            const char* a1 = cA + (size_t)(t + 1) * kstep;
            const char* a2 = last ? nA : cA + (size_t)(t + 2) * kstep; const char* b2 = last ? nB : cB + (size_t)(t + 2) * kstep;
            const char* a3 = a2 + kstep; const char* b3 = b2 + kstep;
            if (last && has_next) S.a_ready(nxt);
            if constexpr (SP2) {
            PG8_LDB(B0, 0, 0); PG8_LDB(B1, 0, 1); PG8_SCHED; PG8_LDA(At, 0, 0); PG8_STAGE(PG8_SA(1, 1), a1 + hstepA, voffA);
            PG8_WAIT_V(8); PG8_WAIT_L(0); PG8_BAR; PG8_MMA(0, 0, At, B0); PG8_MMA(0, 1, At, B1); PG8_BAR; PG8_SCHED;
            PG8_LDA(At, 0, 1); PG8_STAGE(PG8_SB(0, 0), b2, voffB); PG8_STAGE(PG8_SB(0, 1), b2 + hstep, voffB); PG8_STAGE(PG8_SA(0, 0), a2, voffA);
            PG8_WAIT_V(8); PG8_WAIT_L(0); PG8_BAR; PG8_MMA(1, 0, At, B0); PG8_MMA(1, 1, At, B1); PG8_BAR; PG8_SCHED;
            PG8_LDB(B0, 1, 0); PG8_LDB(B1, 1, 1); PG8_SCHED; PG8_LDA(At, 1, 0); PG8_STAGE(PG8_SA(0, 1), a2 + hstepA, voffA);
            PG8_WAIT_V(8); PG8_WAIT_L(0); PG8_BAR; PG8_MMA(0, 0, At, B0); PG8_MMA(0, 1, At, B1); PG8_BAR; PG8_SCHED;
            PG8_LDA(At, 1, 1); PG8_STAGE(PG8_SB(1, 0), b3, voffB); PG8_STAGE(PG8_SB(1, 1), b3 + hstep, voffB); PG8_STAGE(PG8_SA(1, 0), a3, voffA);
            PG8_WAIT_V(8); PG8_WAIT_L(0); PG8_BAR; PG8_MMA(1, 0, At, B0); PG8_MMA(1, 1, At, B1); PG8_BAR; PG8_SCHED;
            } else {
            PG8_LDB(B0, 0, 0); PG8_SCHED; PG8_LDA(At, 0, 0); PG8_STAGE(PG8_SA(1, 1), a1 + hstepA, voffA);
            PG8_WAIT_L(8); PG8_BAR; PG8_WAIT_L(0); PG8_MMA(0, 0, At, B0); PG8_BAR; PG8_SCHED;
            PG8_LDB(B1, 0, 1); PG8_STAGE(PG8_SB(0, 0), b2, voffB);
            PG8_BAR; PG8_WAIT_L(0); PG8_MMA(0, 1, At, B1); PG8_BAR;
            PG8_LDA(At, 0, 1); PG8_STAGE(PG8_SA(0, 0), a2, voffA);
            PG8_BAR; PG8_WAIT_L(0); PG8_MMA(1, 0, At, B0); PG8_BAR; PG8_SCHED;
            PG8_STAGE(PG8_SB(0, 1), b2 + hstep, voffB);
            PG8_WAIT_V(6); PG8_BAR; PG8_MMA(1, 1, At, B1); PG8_BAR;
            PG8_LDB(B0, 1, 0); PG8_SCHED; PG8_LDA(At, 1, 0); PG8_STAGE(PG8_SA(0, 1), a2 + hstepA, voffA);
            PG8_WAIT_L(8); PG8_BAR; PG8_WAIT_L(0); PG8_MMA(0, 0, At, B0); PG8_BAR; PG8_SCHED;
            PG8_LDB(B1, 1, 1); PG8_STAGE(PG8_SB(1, 0), b3, voffB);
            PG8_BAR; PG8_WAIT_L(0); PG8_MMA(0, 1, At, B1); PG8_BAR;
            PG8_LDA(At, 1, 1); PG8_STAGE(PG8_SA(1, 0), a3, voffA);
            PG8_BAR; PG8_WAIT_L(0); PG8_MMA(1, 0, At, B0); PG8_BAR; PG8_SCHED;
            PG8_STAGE(PG8_SB(1, 1), b3 + hstep, voffB);
            PG8_WAIT_V(6); PG8_BAR; PG8_MMA(1, 1, At, B1); PG8_BAR;
            }
        }
        if constexpr (ALIGN_EPI) { if (wr == 0) PG8_BAR; }
        if constexpr (!Epi::AFTER_DRAIN) { E(acc, cur, wr, wc, fr, fq); S.done(cur); }
        if (!has_next) break;
#pragma unroll
        for (int a = 0; a < 2; ++a)
#pragma unroll
            for (int b = 0; b < 2; ++b)
#pragma unroll
                for (int m = 0; m < 4; ++m)
#pragma unroll
                    for (int n = 0; n < 2; ++n) acc[a][b][m][n] = (f32x4){0.f, 0.f, 0.f, 0.f};
        cur = nxt; cA = nA; cB = nB; ++ui;
        if constexpr (ALIGN_EPI) { if (wr == 1) PG8_BAR; }
    }
    PG8_WAIT_V(0);
    if constexpr (!ALIGN_EPI) { if (wr == 0) PG8_BAR; }
    PG8_BAR;
    if constexpr (Epi::AFTER_DRAIN) { E.fused(acc, cur, wr, wc, fr, fq, lds, wid, lane); S.done(cur); }
#undef PG8_SA
#undef PG8_SB
#undef PG8_STAGE
#undef PG8_LDA
#undef PG8_LDB
#undef PG8_MMA
#undef PG8_WAIT_V
#undef PG8_WAIT_L
#undef PG8_BAR
#undef PG8_SCHED
}
}

#define LAS __attribute__((address_space(3)))
typedef unsigned short bf16_t;
typedef short bf16x8 __attribute__((ext_vector_type(8)));
typedef short s16x4 __attribute__((ext_vector_type(4)));
typedef short v4i16_t __attribute__((ext_vector_type(4)));
typedef float f32x2 __attribute__((ext_vector_type(2)));
typedef float f32x4 __attribute__((ext_vector_type(4)));
typedef float f32x16 __attribute__((ext_vector_type(16)));
typedef __bf16 bf16x2_t __attribute__((ext_vector_type(2)));
typedef unsigned u32x2 __attribute__((ext_vector_type(2)));
typedef unsigned u32x4 __attribute__((ext_vector_type(4)));

constexpr int DM = 1024, TP = 32768, TS = 65536, T = TP + TS, SP = 16384, SSQ = 8192;
constexpr int DFF = 2816, NGU = 2 * DFF, NIN = 3584, NQKV = 3072, PW = 3072;
constexpr int NUNITS_RET = (T / 128) * 4;
constexpr float LOG2E = 1.4426950408889634f;
constexpr float LAMBDA_INIT = 0.35550906758f;
constexpr int PC_AB = 0, PC_SG = 512, PC_U = 1024, PC_Q = 1536, PC_K = 2048, PC_V = 2560;

constexpr size_t MiB = 1u << 20;
constexpr size_t WS_WIN = 1 * MiB, WS_WOUT0 = 8 * MiB, WS_WGU0 = 10 * MiB, WS_WD0 = 21 * MiB, WS_WQKV = 27 * MiB, WS_WO1 = 33 * MiB, WS_WGU1 = 35 * MiB, WS_WD1 = 46 * MiB;
constexpr size_t WS_TAB128 = 52 * MiB, WS_TAB64 = 60 * MiB, WS_PART = 64 * MiB, WS_XN = 72 * MiB, WS_BIG = 264 * MiB, WS_END = 840 * MiB;
static_assert(WS_XN + (size_t)T * DM * 2 <= WS_BIG && WS_BIG + (size_t)T * PW * 2 <= WS_END, "ws map");
static_assert((size_t)2 * NUNITS_RET * 16384 * 2 <= (size_t)T * DM * 2, "retention states alias XN");
constexpr int LDS_BYTES = 148480;

__device__ __forceinline__ unsigned pk2(float lo, float hi) { f32x2 v = {lo, hi}; bf16x2_t b = __builtin_convertvector(v, bf16x2_t); return __builtin_bit_cast(unsigned, b); }
__device__ __forceinline__ float bflo(unsigned u) { return __uint_as_float(u << 16); }
__device__ __forceinline__ float bfhi(unsigned u) { return __uint_as_float(u & 0xffff0000u); }
__device__ __forceinline__ float silu_f(float x) { return x * __builtin_amdgcn_rcpf(1.f + __expf(-x)); }
__device__ __forceinline__ int tok_pos(int row) { return row < TP ? (row & (SP - 1)) : (row & (SSQ - 1)); }
__device__ __forceinline__ s16x4 ldtr(const LAS unsigned char* p) { return __builtin_bit_cast(s16x4, __builtin_amdgcn_ds_read_tr16_b64_v4i16((LAS v4i16_t*)p)); }
__device__ __forceinline__ bf16x8 cat8(s16x4 a, s16x4 b) { return (bf16x8){a[0], a[1], a[2], a[3], b[0], b[1], b[2], b[3]}; }
__device__ __forceinline__ float wave_sum(float v) {
#pragma unroll
    for (int o = 1; o < 64; o <<= 1) v += __shfl_xor(v, o);
    return v;
}
__device__ __forceinline__ float row_scale(const float* part, int row) {
    const f32x4* p = (const f32x4*)(part + (size_t)row * 16);
    const f32x4 a = p[0], b = p[1], c = p[2], d = p[3];
    const float s = ((a[0] + a[1]) + (a[2] + a[3])) + ((b[0] + b[1]) + (b[2] + b[3])) + ((c[0] + c[1]) + (c[2] + c[3])) + ((d[0] + d[1]) + (d[2] + d[3]));
    return __builtin_amdgcn_rsqf(s * (1.0f / 1024.0f) + 1e-6f);
}

struct EpiInProj {
    static constexpr bool PERM = true, AFTER_DRAIN = false;
    bf16_t* O; const float* tab;
    __device__ __forceinline__ void operator()(const pg8::f32x4 (&acc)[2][2][4][2], const pg8::Unit& u, int wr, int wc, int fr, int fq) const {
        const int pn = u.pn, row0 = u.pm * 256 + wr * 64 + fr;
        if (pn < 4 || pn >= 12) {
            const bool sl = (pn >= 2 && pn < 4);
            const int oc = (pn < 4 ? pn * 256 : PC_V + (pn - 12) * 256) + wc * 32 + 8 * fq;
#pragma unroll
            for (int ai = 0; ai < 2; ++ai)
#pragma unroll
                for (int m = 0; m < 4; ++m) { bf16_t* rp = O + (size_t)(row0 + ai * 128 + m * 16) * PW + oc;
#pragma unroll
                    for (int bj = 0; bj < 2; ++bj) { f32x4 v0 = acc[ai][bj][m][0], v1 = acc[ai][bj][m][1];
                        if (sl) { v0 = (f32x4){silu_f(v0[0]), silu_f(v0[1]), silu_f(v0[2]), silu_f(v0[3])}; v1 = (f32x4){silu_f(v1[0]), silu_f(v1[1]), silu_f(v1[2]), silu_f(v1[3])}; }
                        u32x4 w; w.x = pk2(v0[0], v0[1]); w.y = pk2(v0[2], v0[3]); w.z = pk2(v1[0], v1[1]); w.w = pk2(v1[2], v1[3]);
                        *(u32x4*)(rp + bj * 128) = w; } }
        } else if (pn < 8) {
            const int oc = PC_U + (pn - 4) * 128 + wc * 16 + 4 * fq;
#pragma unroll
            for (int ai = 0; ai < 2; ++ai)
#pragma unroll
                for (int m = 0; m < 4; ++m) { bf16_t* rp = O + (size_t)(row0 + ai * 128 + m * 16) * PW + oc;
#pragma unroll
                    for (int bj = 0; bj < 2; ++bj) { const f32x4 v = acc[ai][bj][m][0] * acc[ai][bj][m][1];
                        u32x2 w; w.x = pk2(v[0], v[1]); w.y = pk2(v[2], v[3]); *(u32x2*)(rp + bj * 64) = w; } }
        } else {
            const bool isk = pn >= 10; const float sc = isk ? 0.08838834764831845f : 1.0f;
            const int oc = (isk ? PC_K + (pn - 10) * 256 : PC_Q + (pn - 8) * 256) + wc * 32 + 8 * fq;
            const int f0 = 4 * (4 * wc + fq);
#pragma unroll
            for (int ai = 0; ai < 2; ++ai)
#pragma unroll
                for (int m = 0; m < 4; ++m) { const int row = row0 + ai * 128 + m * 16; const f32x4* tp = (const f32x4*)(tab + ((size_t)tok_pos(row) * 64 + f0) * 2);
                    const f32x4 t0 = tp[0], t1 = tp[1]; const f32x4 cs = {t0[0], t0[2], t1[0], t1[2]}, sn = {t0[1], t0[3], t1[1], t1[3]};
                    bf16_t* rp = O + (size_t)row * PW + oc;
#pragma unroll
                    for (int bj = 0; bj < 2; ++bj) { const f32x4 x1 = acc[ai][bj][m][0], x2 = acc[ai][bj][m][1];
                        const f32x4 o1 = (x1 * cs - x2 * sn) * sc, o2 = (x1 * sn + x2 * cs) * sc;
                        u32x4 w; w.x = pk2(o1[0], o1[1]); w.y = pk2(o1[2], o1[3]); w.z = pk2(o2[0], o2[1]); w.w = pk2(o2[2], o2[3]);
                        *(u32x4*)(rp + bj * 128) = w; } }
        }
    }
};
struct EpiQKV {
    static constexpr bool PERM = true, AFTER_DRAIN = false;
    bf16_t* O; const float* tab; const float* part; unsigned* kmax;
    __device__ __forceinline__ void operator()(const pg8::f32x4 (&acc)[2][2][4][2], const pg8::Unit& u, int wr, int wc, int fr, int fq) const {
        const int pn = u.pn, row0 = u.pm * 256 + wr * 64 + fr;
        const int oc = pn * 256 + wc * 32 + 8 * fq;
        if (pn >= 8) {
#pragma unroll
            for (int ai = 0; ai < 2; ++ai)
#pragma unroll
                for (int m = 0; m < 4; ++m) { const int row = row0 + ai * 128 + m * 16; const float rs = row_scale(part, row);
                    bf16_t* rp = O + (size_t)T * 1024 + ((size_t)(2 * (pn - 8)) * T + row) * 256 + 128 + wc * 32 + 8 * fq;
#pragma unroll
                    for (int bj = 0; bj < 2; ++bj) { const f32x4 v0 = acc[ai][bj][m][0] * rs, v1 = acc[ai][bj][m][1] * rs;
                        u32x4 w; w.x = pk2(v0[0], v0[1]); w.y = pk2(v0[2], v0[3]); w.z = pk2(v1[0], v1[1]); w.w = pk2(v1[2], v1[3]);
                        *(u32x4*)(rp + (size_t)bj * T * 256) = w; } }
        } else {
            const float sc = pn < 4 ? 0.125f * LOG2E : 1.0f;
            const int f0 = 4 * (4 * (wc & 1) + fq);
            float kmx0 = 0.f, kmx1 = 0.f;
#pragma unroll
            for (int ai = 0; ai < 2; ++ai)
#pragma unroll
                for (int m = 0; m < 4; ++m) { const int row = row0 + ai * 128 + m * 16; const float rs = row_scale(part, row) * sc;
                    const f32x4* tp = (const f32x4*)(tab + ((size_t)tok_pos(row) * 32 + f0) * 2);
                    const f32x4 t0 = tp[0], t1 = tp[1]; const f32x4 cs = {t0[0], t0[2], t1[0], t1[2]}, sn = {t0[1], t0[3], t1[1], t1[3]};
                    bf16_t* rp = pn < 4 ? O + (size_t)row * 1024 + oc : O + (size_t)T * 1024 + ((size_t)(2 * (pn - 4)) * T + row) * 256 + wc * 32 + 8 * fq;
                    const size_t bjs = pn < 4 ? (size_t)128 : (size_t)T * 256;
#pragma unroll
                    for (int bj = 0; bj < 2; ++bj) { const f32x4 x1 = acc[ai][bj][m][0], x2 = acc[ai][bj][m][1];
                        const f32x4 o1 = (x1 * cs - x2 * sn) * rs, o2 = (x1 * sn + x2 * cs) * rs;
                        u32x4 w; w.x = pk2(o1[0], o1[1]); w.y = pk2(o1[2], o1[3]); w.z = pk2(o2[0], o2[1]); w.w = pk2(o2[2], o2[3]);
                        *(u32x4*)(rp + bj * bjs) = w;
                        if (pn >= 4) { float q2 = ((o1[0] * o1[0] + o1[1] * o1[1]) + (o1[2] * o1[2] + o1[3] * o1[3])) + ((o2[0] * o2[0] + o2[1] * o2[1]) + (o2[2] * o2[2] + o2[3] * o2[3]));
                            q2 += __shfl_xor(q2, 16); q2 += __shfl_xor(q2, 32);
                            if (bj == 0) kmx0 = fmaxf(kmx0, q2); else kmx1 = fmaxf(kmx1, q2); } } }
            if (pn >= 4) {
#pragma unroll
                for (int o_ = 1; o_ < 16; o_ <<= 1) { kmx0 = fmaxf(kmx0, __shfl_xor(kmx0, o_)); kmx1 = fmaxf(kmx1, __shfl_xor(kmx1, o_)); }
                const int r0 = u.pm * 256, seq = r0 < TP ? (r0 >> 14) : 2 + ((r0 - TP) >> 13);
                if (fr == 0 && fq == 0) {
                    __hip_atomic_fetch_max(kmax + ((seq * 16 + 4 * (pn - 4) + (wc >> 1)) * 2 + (wc & 1)), __float_as_uint(kmx0 * 1.02f), __ATOMIC_RELAXED, __HIP_MEMORY_SCOPE_AGENT);
                    __hip_atomic_fetch_max(kmax + ((seq * 16 + 4 * (pn - 4) + 2 + (wc >> 1)) * 2 + (wc & 1)), __float_as_uint(kmx1 * 1.02f), __ATOMIC_RELAXED, __HIP_MEMORY_SCOPE_AGENT); }
            }
        }
    }
};
struct EpiGU {
    static constexpr bool PERM = true, AFTER_DRAIN = false;
    bf16_t* H; const float* part;
    __device__ __forceinline__ void operator()(const pg8::f32x4 (&acc)[2][2][4][2], const pg8::Unit& u, int wr, int wc, int fr, int fq) const {
        const int row0 = u.pm * 256 + wr * 64 + fr, oc = u.pn * 128 + wc * 16 + 4 * fq;
#pragma unroll
        for (int ai = 0; ai < 2; ++ai)
#pragma unroll
            for (int m = 0; m < 4; ++m) { const int row = row0 + ai * 128 + m * 16; const float rs = row_scale(part, row); bf16_t* rp = H + (size_t)row * DFF + oc;
#pragma unroll
                for (int bj = 0; bj < 2; ++bj) { const f32x4 g = acc[ai][bj][m][0] * rs, up = acc[ai][bj][m][1] * rs;
                    const f32x4 hh = {silu_f(g[0]) * up[0], silu_f(g[1]) * up[1], silu_f(g[2]) * up[2], silu_f(g[3]) * up[3]};
                    u32x2 w; w.x = pk2(hh[0], hh[1]); w.y = pk2(hh[2], hh[3]); *(u32x2*)(rp + bj * 64) = w; } }
    }
};
template <bool RES_F32> struct EpiRes {
    static constexpr bool PERM = false, AFTER_DRAIN = false;
    const float* res0; const float* res1; bf16_t* X; float* part;
    __device__ __forceinline__ void operator()(const pg8::f32x4 (&acc)[2][2][4][2], const pg8::Unit& u, int wr, int wc, int fr, int fq) const {
        const int col0 = u.pn * 256 + wc * 32 + 4 * fq;
#pragma unroll
        for (int ai = 0; ai < 2; ++ai)
#pragma unroll
            for (int m = 0; m < 4; ++m) { const int row = u.pm * 256 + ai * 128 + wr * 64 + m * 16 + fr;
                const float* rb = (row < TP ? res0 : res1) + (size_t)row * DM; bf16_t* xr = X + (size_t)row * DM; float ss = 0.f;
#pragma unroll
                for (int bj = 0; bj < 2; ++bj)
#pragma unroll
                    for (int n = 0; n < 2; ++n) { const int col = col0 + bj * 128 + n * 16;
                        f32x4 r;
                        if (RES_F32) r = *(const f32x4*)(rb + col);
                        else { const u32x2 rw = *(const u32x2*)(xr + col); r = (f32x4){bflo(rw.x), bfhi(rw.x), bflo(rw.y), bfhi(rw.y)}; }
                        const f32x4 x = r + acc[ai][bj][m][n];
                        ss += (x[0] * x[0] + x[1] * x[1]) + (x[2] * x[2] + x[3] * x[3]);
                        u32x2 o; o.x = pk2(x[0], x[1]); o.y = pk2(x[2], x[3]); *(u32x2*)(xr + col) = o; }
                ss += __shfl_xor(ss, 16); ss += __shfl_xor(ss, 32); if (fq == 0) part[(size_t)row * 16 + u.pn * 4 + wc] = ss; }
    }
};

enum { MAP_ID = 0, MAP_INPROJ = 1, MAP_GATE = 2, MAP_UP = 3, MAP_QKV = 4 };
__device__ __forceinline__ int dest_row(int map, int n) {
    if (map == MAP_ID) return n;
    if (map == MAP_GATE) return 8 * (n >> 2) + (n & 3);
    if (map == MAP_UP) return 8 * (n >> 2) + 4 + (n & 3);
    if (map == MAP_INPROJ) {
        const int s = n >> 9, o = n & 511;
        if (s == 0) return o;
        if (s == 6) return 512 + o;
        if (s == 1) return 1024 + 8 * (o >> 2) + (o & 3);
        if (s == 2) return 1024 + 8 * (o >> 2) + 4 + (o & 3);
        if (s == 5) return 3072 + o;
        const int hh = o >> 7, d = o & 127, half = d >> 6, f = d & 63;
        return (s == 3 ? 2048 : 2560) + 128 * hh + 8 * (f >> 2) + 4 * half + (f & 3);
    }
    if (n >= 2048) return n;
    { const int hh = n >> 6, d = n & 63, half = d >> 5, f = d & 31; return 64 * hh + 8 * (f >> 2) + 4 * half + (f & 3); }
}
__device__ __forceinline__ void p0_transpose_item(const float* W, int K, int N, bf16_t* WT, int map, LAS float* scr, int item, int lane, const float* ksc = nullptr) {
    const int nblk = N / 32, kb = item / nblk, nb = item % nblk, k0 = 64 * kb, n0 = 32 * nb;
#pragma unroll 8
    for (int i = 0; i < 32; ++i) { const int kk = 2 * i + (lane >> 5); scr[kk * 33 + (lane & 31)] = W[(size_t)(k0 + kk) * N + n0 + (lane & 31)] * (ksc ? ksc[k0 + kk] : 1.0f); }
    asm volatile("s_waitcnt lgkmcnt(0)" ::: "memory");
    const int c = lane & 7;
#pragma unroll
    for (int j = 0; j < 4; ++j) { const int n = (lane >> 3) + 8 * j; const LAS float* s = scr + (8 * c) * 33 + n;
        u32x4 o; o.x = pk2(s[0 * 33], s[1 * 33]); o.y = pk2(s[2 * 33], s[3 * 33]); o.z = pk2(s[4 * 33], s[5 * 33]); o.w = pk2(s[6 * 33], s[7 * 33]);
        *(u32x4*)(WT + (size_t)dest_row(map, n0 + n) * K + k0 + 8 * c) = o; }
    asm volatile("s_waitcnt lgkmcnt(0)" ::: "memory");
}

struct Args {
    const float* in[21]; float* out; unsigned char* ws; int ph_lo, ph_hi, coop, pad;
};

__device__ __forceinline__ void phase_prologue(const Args& a, LAS unsigned char* L, int vcu, int G) {
    const int tid = threadIdx.x, lane = tid & 63, wave = __builtin_amdgcn_readfirstlane(tid >> 6);
    LAS float* scr = (LAS float*)(L + wave * 16384);
    const int gw = vcu * 8 + wave, NGW = G * 8;
    unsigned char* ws = a.ws;
    constexpr int I_IN = 16 * (NIN / 32), I_SQ = 16 * 32, I_GU = 16 * (DFF / 32), I_DN = (DFF / 64) * 32, I_QKV = 16 * (NQKV / 32);
    constexpr int NITEMS = I_IN + I_SQ + 2 * I_GU + I_DN + I_QKV + I_SQ + 2 * I_GU + I_DN;
    for (int it = gw; it < NITEMS; it += NGW) {
        int r = it;
        if (r < I_IN) { p0_transpose_item(a.in[5], DM, NIN, (bf16_t*)(ws + WS_WIN), MAP_INPROJ, scr, r, lane, a.in[2]); continue; } r -= I_IN;
        if (r < I_SQ) { p0_transpose_item(a.in[10], DM, DM, (bf16_t*)(ws + WS_WOUT0), MAP_ID, scr, r, lane); continue; } r -= I_SQ;
        if (r < I_GU) { p0_transpose_item(a.in[18], DM, DFF, (bf16_t*)(ws + WS_WGU0), MAP_GATE, scr, r, lane, a.in[3]); continue; } r -= I_GU;
        if (r < I_GU) { p0_transpose_item(a.in[19], DM, DFF, (bf16_t*)(ws + WS_WGU0), MAP_UP, scr, r, lane, a.in[3]); continue; } r -= I_GU;
        if (r < I_DN) { p0_transpose_item(a.in[20], DFF, DM, (bf16_t*)(ws + WS_WD0), MAP_ID, scr, r, lane); continue; } r -= I_DN;
        if (r < I_QKV) { p0_transpose_item(a.in[11], DM, NQKV, (bf16_t*)(ws + WS_WQKV), MAP_QKV, scr, r, lane, a.in[2] + DM); continue; } r -= I_QKV;
        if (r < I_SQ) { p0_transpose_item(a.in[17], DM, DM, (bf16_t*)(ws + WS_WO1), MAP_ID, scr, r, lane); continue; } r -= I_SQ;
        if (r < I_GU) { p0_transpose_item(a.in[18] + (size_t)DM * DFF, DM, DFF, (bf16_t*)(ws + WS_WGU1), MAP_GATE, scr, r, lane, a.in[3] + DM); continue; } r -= I_GU;
        if (r < I_GU) { p0_transpose_item(a.in[19] + (size_t)DM * DFF, DM, DFF, (bf16_t*)(ws + WS_WGU1), MAP_UP, scr, r, lane, a.in[3] + DM); continue; } r -= I_GU;
        p0_transpose_item(a.in[20] + (size_t)DFF * DM, DFF, DM, (bf16_t*)(ws + WS_WD1), MAP_ID, scr, r, lane);
    }
    {
        const int gt = vcu * 512 + tid, NT = G * 512;
        f32x2* t128 = (f32x2*)(ws + WS_TAB128); f32x2* t64 = (f32x2*)(ws + WS_TAB64);
        for (int i = gt; i < SP * 96; i += NT) {
            int pos, f; double e; f32x2* dst;
            if (i < SP * 64) { pos = i >> 6; f = i & 63; e = (double)f * (1.0 / 64.0); dst = t128 + i; }
            else { const int j = i - SP * 64; pos = j >> 5; f = j & 31; e = (double)f * (1.0 / 32.0); dst = t64 + j; }
            const float inv = (float)exp2(-e * 13.287712379549449);
            const float angf = (float)pos * inv;
            double rev = (double)angf * 0.15915494309189535; rev -= floor(rev);
            const float rv = (float)rev;
            *dst = (f32x2){__builtin_amdgcn_cosf(rv), __builtin_amdgcn_sinf(rv)};
        }
    }
    {
        bf16_t* XN = (bf16_t*)(ws + WS_XN);
        for (int m = gw; m < T; m += NGW) {
            const float* xr = (m < TP ? a.in[0] + (size_t)m * DM : a.in[1] + (size_t)(m - TP) * DM);
            f32x4 v[4]; float s = 0.f;
#pragma unroll
            for (int j = 0; j < 4; ++j) { v[j] = ((const f32x4*)xr)[lane + 64 * j]; s += (v[j][0] * v[j][0] + v[j][1] * v[j][1]) + (v[j][2] * v[j][2] + v[j][3] * v[j][3]); }
            const float rs = __builtin_amdgcn_rsqf(wave_sum(s) * (1.f / 1024.f) + 1e-6f);
            u32x2* o8 = (u32x2*)(XN + (size_t)m * DM);
#pragma unroll
            for (int j = 0; j < 4; ++j) { const f32x4 y = v[j] * rs; u32x2 o; o.x = pk2(y[0], y[1]); o.y = pk2(y[2], y[3]); o8[lane + 64 * j] = o; }
        }
    }
}

constexpr int RP = 288, RIMG = 128 * RP;
__device__ __forceinline__ void ret_kv_unit(LAS unsigned char* L, const bf16_t* PROJ, bf16_t* ST, int u, const float* decf, const float* decb) {
    const int tid = threadIdx.x, lane = tid & 63, wid = __builtin_amdgcn_readfirstlane(tid >> 6);
    const int cgk = u >> 2, h = u & 3; const size_t row0 = (size_t)cgk * 128;
    const float l2f = -__expf(decf[h]) * LOG2E, l2b = -__expf(decb[h]) * LOG2E;
#pragma unroll
    for (int c = 0; c < 4; ++c) { const int idx = tid + 512 * c, row = idx >> 4, ch = idx & 15;
        const u32x4 kr = *(const u32x4*)(PROJ + (row0 + row) * PW + PC_K + 128 * h + 8 * ch);
        const u32x4 vr = *(const u32x4*)(PROJ + (row0 + row) * PW + PC_V + 128 * h + 8 * ch);
        const float df = __builtin_amdgcn_exp2f(l2f * (float)(127 - row)), db = __builtin_amdgcn_exp2f(l2b * (float)row);
        u32x4 kf, kb;
        kf.x = pk2(bflo(kr.x) * df, bfhi(kr.x) * df); kf.y = pk2(bflo(kr.y) * df, bfhi(kr.y) * df); kf.z = pk2(bflo(kr.z) * df, bfhi(kr.z) * df); kf.w = pk2(bflo(kr.w) * df, bfhi(kr.w) * df);
        kb.x = pk2(bflo(kr.x) * db, bfhi(kr.x) * db); kb.y = pk2(bflo(kr.y) * db, bfhi(kr.y) * db); kb.z = pk2(bflo(kr.z) * db, bfhi(kr.z) * db); kb.w = pk2(bflo(kr.w) * db, bfhi(kr.w) * db);
        *(LAS u32x4*)(L + 0 * RIMG + row * RP + ch * 16) = kf;
        *(LAS u32x4*)(L + 1 * RIMG + row * RP + ch * 16) = kb;
        *(LAS u32x4*)(L + 2 * RIMG + row * RP + ch * 16) = vr; }
    __syncthreads();
    const int dir = wid & 1, dblk = wid >> 1, li = lane & 15, dsub = (lane >> 4) & 1, hi = lane >> 5;
    const int tb = (8 * hi + (li >> 2)) * RP + (16 * dsub + 4 * (li & 3)) * 2;
    const LAS unsigned char* KA = L + dir * RIMG + tb + dblk * 64;
    const LAS unsigned char* VB = L + 2 * RIMG + tb;
    f32x16 acc[4];
#pragma unroll
    for (int e = 0; e < 4; ++e) acc[e] = (f32x16){};
#pragma unroll
    for (int st = 0; st < 8; ++st) {
        const bf16x8 af = cat8(ldtr(KA + (16 * st) * RP), ldtr(KA + (16 * st + 4) * RP));
#pragma unroll
        for (int e = 0; e < 4; ++e) { const bf16x8 bfv = cat8(ldtr(VB + (16 * st) * RP + e * 64), ldtr(VB + (16 * st + 4) * RP + e * 64));
            acc[e] = __builtin_amdgcn_mfma_f32_32x32x16_bf16(af, bfv, acc[e], 0, 0, 0); }
    }
    bf16_t* dst = ST + ((size_t)dir * NUNITS_RET + u) * 16384;
#pragma unroll
    for (int e = 0; e < 4; ++e)
#pragma unroll
        for (int r = 0; r < 16; ++r) { const int d = 32 * dblk + (r & 3) + 8 * (r >> 2) + 4 * hi;
            dst[d * 128 + 32 * e + (lane & 31)] = (bf16_t)(pk2(acc[e][r], 0.f) & 0xffffu); }
    __syncthreads();
}
__device__ __forceinline__ void phase_scan(const Args& a, int vcu, int G) {
    bf16_t* ST = (bf16_t*)(a.ws + WS_XN);
    const float* decf = a.in[7]; const float* decb = a.in[8];
    const int gt = vcu * 512 + threadIdx.x, NT = G * 512;
    for (int s = gt; s < 131072; s += NT) {
        if (s < 65536) {
            const int dir = s >> 15, r = s & 32767, seq = r >> 12, eg = r & 4095, b = seq >> 2, h = seq & 3;
            const float lg = -__expf((dir ? decb : decf)[h]); const float cd = __expf(lg * 128.f);
            float s0 = 0.f, s1 = 0.f, s2 = 0.f, s3 = 0.f;
#pragma unroll 8
            for (int i = 0; i < 128; ++i) { const int n = dir ? 127 - i : i;
                u32x2* p = (u32x2*)(ST + ((size_t)dir * NUNITS_RET + (size_t)(b * 128 + n) * 4 + h) * 16384 + eg * 4);
                const u32x2 kv = *p; u32x2 o; o.x = pk2(s0, s1); o.y = pk2(s2, s3); *p = o;
                s0 = s0 * cd + bflo(kv.x); s1 = s1 * cd + bfhi(kv.x); s2 = s2 * cd + bflo(kv.y); s3 = s3 * cd + bfhi(kv.y); }
        } else {
#pragma unroll 1
            for (int rep = 0; rep < 2; ++rep) { const int it = (s - 65536) + rep * 65536;
                const int dir = it >> 16, r = it & 65535, seq = r >> 11, eg = r & 2047, b = seq >> 2, h = seq & 3;
                const float lg = -__expf((dir ? decb : decf)[h]); const float cd = __expf(lg * 128.f);
                float st[8];
#pragma unroll
                for (int k = 0; k < 8; ++k) st[k] = 0.f;
#pragma unroll 4
                for (int i = 0; i < 64; ++i) { const int n = dir ? 63 - i : i;
                    u32x4* p = (u32x4*)(ST + ((size_t)dir * NUNITS_RET + (size_t)(256 + b * 64 + n) * 4 + h) * 16384 + eg * 8);
                    const u32x4 kv = *p; u32x4 o; o.x = pk2(st[0], st[1]); o.y = pk2(st[2], st[3]); o.z = pk2(st[4], st[5]); o.w = pk2(st[6], st[7]); *p = o;
                    st[0] = st[0] * cd + bflo(kv.x); st[1] = st[1] * cd + bfhi(kv.x); st[2] = st[2] * cd + bflo(kv.y); st[3] = st[3] * cd + bfhi(kv.y);
                    st[4] = st[4] * cd + bflo(kv.z); st[5] = st[5] * cd + bfhi(kv.z); st[6] = st[6] * cd + bflo(kv.w); st[7] = st[7] * cd + bfhi(kv.w); } }
        }
    }
}
__device__ __forceinline__ void ret_out_unit(LAS unsigned char* L, bf16_t* PROJ, const bf16_t* ST, int u, const float* decf, const float* decb, const float* gnw) {
    const int tid = threadIdx.x, lane = tid & 63, wid = __builtin_amdgcn_readfirstlane(tid >> 6);
    const int cgk = u >> 2, h = u & 3; const size_t row0 = (size_t)cgk * 128;
    const float l2f = -__expf(decf[h]) * LOG2E, l2b = -__expf(decb[h]) * LOG2E;
    const bf16_t* Sf = ST + (size_t)u * 16384; const bf16_t* Sb = ST + ((size_t)NUNITS_RET + u) * 16384;
#pragma unroll 1
    for (int c = 0; c < 4; ++c) { const int idx = tid + 512 * c, row = idx >> 4, ch = idx & 15;
        *(LAS u32x4*)(L + 0 * RIMG + row * RP + ch * 16) = *(const u32x4*)(PROJ + (row0 + row) * PW + PC_K + 128 * h + 8 * ch);
        *(LAS u32x4*)(L + 1 * RIMG + row * RP + ch * 16) = *(const u32x4*)(PROJ + (row0 + row) * PW + PC_V + 128 * h + 8 * ch);
        *(LAS u32x4*)(L + 2 * RIMG + row * RP + ch * 16) = *(const u32x4*)(Sf + row * 128 + 8 * ch);
        *(LAS u32x4*)(L + 3 * RIMG + row * RP + ch * 16) = *(const u32x4*)(Sb + row * 128 + 8 * ch); }
    const int i16 = lane & 15, g = lane >> 4, ia = 16 * wid + i16;
    bf16x8 qf[4];
#pragma unroll
    for (int st = 0; st < 4; ++st) qf[st] = *(const bf16x8*)(PROJ + (row0 + ia) * PW + PC_Q + 128 * h + 32 * st + 8 * g);
    __syncthreads();
    const int tb = (i16 >> 2) * RP + 8 * (i16 & 3);
    pg8::f32x4 acc[8];
#pragma unroll
    for (int et = 0; et < 8; ++et) acc[et] = (pg8::f32x4){0.f, 0.f, 0.f, 0.f};
    const float qdf = __builtin_amdgcn_exp2f(l2f * (float)(ia + 1)), qdb = __builtin_amdgcn_exp2f(l2b * (float)(128 - ia));
    {
        const LAS unsigned char* SA = L + 2 * RIMG + tb + (8 * g) * RP;
#pragma unroll
        for (int et = 0; et < 8; ++et)
#pragma unroll
            for (int st = 0; st < 4; ++st) { const bf16x8 af = cat8(ldtr(SA + (32 * st) * RP + et * 32), ldtr(SA + (32 * st + 4) * RP + et * 32));
                acc[et] = __builtin_amdgcn_mfma_f32_16x16x32_bf16(af, qf[st], acc[et], 0, 0, 0); }
        const float ratio = qdf / qdb;
#pragma unroll
        for (int et = 0; et < 8; ++et) acc[et] = acc[et] * ratio;
    }
    {
        const LAS unsigned char* SA = L + 3 * RIMG + tb + (8 * g) * RP;
#pragma unroll
        for (int et = 0; et < 8; ++et)
#pragma unroll
            for (int st = 0; st < 4; ++st) { const bf16x8 af = cat8(ldtr(SA + (32 * st) * RP + et * 32), ldtr(SA + (32 * st + 4) * RP + et * 32));
                acc[et] = __builtin_amdgcn_mfma_f32_16x16x32_bf16(af, qf[st], acc[et], 0, 0, 0); }
#pragma unroll
        for (int et = 0; et < 8; ++et) acc[et] = acc[et] * qdb;
    }
    bf16x8 pf[4];
    {
        pg8::f32x4 sT[8];
        const LAS unsigned char* KA = L + i16 * RP + (8 * g) * 2;
#pragma unroll
        for (int jt = 0; jt < 8; ++jt) { sT[jt] = (pg8::f32x4){0.f, 0.f, 0.f, 0.f};
#pragma unroll
            for (int st = 0; st < 4; ++st) { const bf16x8 af = *(const LAS bf16x8*)(KA + (16 * jt) * RP + st * 64);
                sT[jt] = __builtin_amdgcn_mfma_f32_16x16x32_bf16(af, qf[st], sT[jt], 0, 0, 0); }
#pragma unroll
            for (int r = 0; r < 4; ++r) { const int j = 16 * jt + 4 * g + r, diff = ia - j;
                const float dv = diff >= 0 ? __builtin_amdgcn_exp2f(l2f * (float)diff) : __builtin_amdgcn_exp2f(l2b * (float)(-diff));
                sT[jt][r] *= dv; } }
#pragma unroll
        for (int s = 0; s < 4; ++s) { u32x4 w; w.x = pk2(sT[2 * s][0], sT[2 * s][1]); w.y = pk2(sT[2 * s][2], sT[2 * s][3]); w.z = pk2(sT[2 * s + 1][0], sT[2 * s + 1][1]); w.w = pk2(sT[2 * s + 1][2], sT[2 * s + 1][3]);
            pf[s] = __builtin_bit_cast(bf16x8, w); }
    }
    {
        const LAS unsigned char* VA = L + 1 * RIMG + tb + (4 * g) * RP;
#pragma unroll
        for (int et = 0; et < 8; ++et)
#pragma unroll
            for (int s = 0; s < 4; ++s) { const bf16x8 af = cat8(ldtr(VA + (32 * s) * RP + et * 32), ldtr(VA + (32 * s + 16) * RP + et * 32));
                acc[et] = __builtin_amdgcn_mfma_f32_16x16x32_bf16(af, pf[s], acc[et], 0, 0, 0); }
    }
    float sm = 0.f;
#pragma unroll
    for (int et = 0; et < 8; ++et) sm += (acc[et][0] + acc[et][1]) + (acc[et][2] + acc[et][3]);
    sm += __shfl_xor(sm, 16); sm += __shfl_xor(sm, 32);
    const float mu = sm * (1.f / 128.f); float vs = 0.f;
#pragma unroll
    for (int et = 0; et < 8; ++et) { acc[et] = acc[et] - mu; vs += (acc[et][0] * acc[et][0] + acc[et][1] * acc[et][1]) + (acc[et][2] * acc[et][2] + acc[et][3] * acc[et][3]); }
    vs += __shfl_xor(vs, 16); vs += __shfl_xor(vs, 32);
    const float rstd = __builtin_amdgcn_rsqf(vs * (1.f / 128.f) + 1e-5f);
    bf16_t* yrow = PROJ + (row0 + ia) * PW + PC_SG + 128 * h + 4 * g;
    const float* gw = gnw + 128 * h + 4 * g;
#pragma unroll
    for (int et = 0; et < 8; ++et) { const u32x2 sg = *(const u32x2*)(yrow + 16 * et); const f32x4 gn = *(const f32x4*)(gw + 16 * et);
        u32x2 o; o.x = pk2(acc[et][0] * rstd * gn[0] * bflo(sg.x), acc[et][1] * rstd * gn[1] * bfhi(sg.x)); o.y = pk2(acc[et][2] * rstd * gn[2] * bflo(sg.y), acc[et][3] * rstd * gn[3] * bfhi(sg.y));
        *(u32x2*)(yrow + 16 * et) = o; }
    __syncthreads();
}
__device__ __forceinline__ void phase_conv(const Args& a, int vcu, int G) {
    bf16_t* PROJ = (bf16_t*)(a.ws + WS_BIG); const float* cw = a.in[6];
    const int gt = vcu * 512 + threadIdx.x, NT = G * 512;
    for (int it = gt; it < T * 64; it += NT) {
        const int row = it >> 6, c8 = it & 63, pos = tok_pos(row), S = row < TP ? SP : SSQ;
        const bf16_t* up = PROJ + (size_t)row * PW + PC_U + 8 * c8;
        const u32x4 z = {0u, 0u, 0u, 0u};
        const u32x4 uc = *(const u32x4*)up, um = pos > 0 ? *(const u32x4*)(up - PW) : z, un = pos < S - 1 ? *(const u32x4*)(up + PW) : z;
        bf16_t* ap = PROJ + (size_t)row * PW + PC_AB + 8 * c8;
        const u32x4 ab = *(const u32x4*)ap;
        const f32x4 w0a = *(const f32x4*)(cw + 8 * c8), w0b = *(const f32x4*)(cw + 8 * c8 + 4), w1a = *(const f32x4*)(cw + 512 + 8 * c8), w1b = *(const f32x4*)(cw + 512 + 8 * c8 + 4),
                    w2a = *(const f32x4*)(cw + 1024 + 8 * c8), w2b = *(const f32x4*)(cw + 1024 + 8 * c8 + 4);
        u32x4 o;
#define CONV2(W, k0, k1, wa0, wa1, wb0, wb1, wc0, wc1) pk2(bflo(ab.W) * (wa0 * bflo(um.W) + wb0 * bflo(uc.W) + wc0 * bflo(un.W)), bfhi(ab.W) * (wa1 * bfhi(um.W) + wb1 * bfhi(uc.W) + wc1 * bfhi(un.W)))
        o.x = CONV2(x, 0, 1, w0a[0], w0a[1], w1a[0], w1a[1], w2a[0], w2a[1]);
        o.y = CONV2(y, 2, 3, w0a[2], w0a[3], w1a[2], w1a[3], w2a[2], w2a[3]);
        o.z = CONV2(z, 4, 5, w0b[0], w0b[1], w1b[0], w1b[1], w2b[0], w2b[1]);
        o.w = CONV2(w, 6, 7, w0b[2], w0b[3], w1b[2], w1b[3], w2b[2], w2b[3]);
#undef CONV2
        *(u32x4*)ap = o;
    }
}

constexpr int ASLOT = 16384, AXP = 132;
__device__ __forceinline__ int swz_f(int row) { return ((row & 3) << 2) | ((row >> 2) & 3); }
__device__ __forceinline__ void glds16(const void* sbase, unsigned voff, unsigned lds_dst) { unsigned keep;
    asm volatile("s_mov_b32 %0, m0\n\ts_mov_b32 m0, %3\n\ts_nop 0\n\tglobal_load_lds_dwordx4 %1, %2\n\ts_mov_b32 m0, %0" : "=&s"(keep) : "v"(voff), "s"(sbase), "s"(lds_dst) : "memory"); }
__device__ __forceinline__ void glds16x4(const void* k0, const void* k1, const void* v0, const void* v1, unsigned voff, unsigned lk0, unsigned lk1, unsigned lv0, unsigned lv1) { unsigned keep;
    asm volatile("s_mov_b32 %0, m0\n\t"
                 "s_mov_b32 m0, %6\n\ts_nop 0\n\tglobal_load_lds_dwordx4 %1, %2\n\t"
                 "s_mov_b32 m0, %7\n\ts_nop 0\n\tglobal_load_lds_dwordx4 %1, %3\n\t"
                 "s_mov_b32 m0, %8\n\ts_nop 0\n\tglobal_load_lds_dwordx4 %1, %4\n\t"
                 "s_mov_b32 m0, %9\n\ts_nop 0\n\tglobal_load_lds_dwordx4 %1, %5\n\t"
                 "s_mov_b32 m0, %0"
                 : "=&s"(keep) : "v"(voff), "s"(k0), "s"(k1), "s"(v0), "s"(v1), "s"(lk0), "s"(lk1), "s"(lv0), "s"(lv1) : "memory"); }
__device__ __forceinline__ float rowmax32(const f32x16& a, const f32x16& b) {
    float m0 = fmaxf(fmaxf(a[0], a[1]), b[0]), m1 = fmaxf(fmaxf(a[2], a[3]), b[1]);
    m0 = fmaxf(fmaxf(m0, b[2]), b[3]);
#pragma unroll
    for (int r = 4; r < 16; r += 4) { m0 = fmaxf(fmaxf(m0, a[r]), a[r + 1]); m1 = fmaxf(fmaxf(m1, a[r + 2]), a[r + 3]); m0 = fmaxf(fmaxf(m0, b[r]), b[r + 1]); m1 = fmaxf(fmaxf(m1, b[r + 2]), b[r + 3]); }
    const float m = fmaxf(m0, m1);
    auto rr = __builtin_amdgcn_permlane32_swap(__float_as_uint(m), __float_as_uint(m), false, false);
    return fmaxf(__uint_as_float(rr[0]), __uint_as_float(rr[1]));
}
#define ASB() __builtin_amdgcn_sched_barrier(0)
__device__ __forceinline__ void attn_unit(LAS unsigned char* L, bf16_t* QKV, size_t rowbase, int S, int h, int qb, float lam, const float* subln, unsigned* kmax) {
    const int tid = threadIdx.x, lane = tid & 63, wid = __builtin_amdgcn_readfirstlane(tid >> 6);
    const int r32 = lane & 31, hi = lane >> 5, qblk = wid & 3, hd = wid >> 2;
    const int li = lane & 15, dsub = (lane >> 4) & 1, q_ = li >> 2, p_ = li & 3;
    const size_t qrow = rowbase + (size_t)qb * 128 + qblk * 32 + r32;
    bf16x8 qf[4];
#pragma unroll
    for (int st = 0; st < 4; ++st) qf[st] = *(const bf16x8*)(QKV + qrow * 1024 + 128 * h + 64 * hd + 16 * st + 8 * hi);
    const int drow = lane >> 4, dch = (lane & 15) ^ ((drow << 2) | (wid & 3));
    const bf16_t* const kbase = QKV + (size_t)T * 1024 + ((size_t)h * T + rowbase) * 256;
    const unsigned kgo = (unsigned)(((4 * wid + drow) * 256 + 8 * dch) * 2);
    const unsigned l0 = (unsigned)(uintptr_t)L;
    const unsigned dK = (unsigned)__builtin_amdgcn_readfirstlane((int)(l0 + wid * 1024)), dV = dK + 4 * ASLOT;
#define DMA_K(t, slot) do { const bf16_t* p_ = kbase + (size_t)(64 * (t)) * 256; glds16(p_, kgo, dK + (slot) * ASLOT); glds16(p_ + (size_t)32 * 256, kgo, dK + (slot) * ASLOT + 8192); } while (0)
#define DMA_V(t, slot) do { const bf16_t* p_ = kbase + (size_t)(64 * (t)) * 256 + 128; glds16(p_, kgo, dV + (slot) * ASLOT); glds16(p_ + (size_t)32 * 256, kgo, dV + (slot) * ASLOT + 8192); } while (0)
#define DMA_WAIT_BAR() do { asm volatile("s_waitcnt vmcnt(0)" ::: "memory"); __syncthreads(); } while (0)
#define DMA_WAIT8_BAR() do { asm volatile("s_waitcnt vmcnt(8)" ::: "memory"); __syncthreads(); } while (0)
    const int kb0 = 256 * r32 + 16 * ((8 * hd + hi) ^ swz_f(r32));
    const int vb0 = 4 * ASLOT + 256 * (4 * hi + q_) + 16 * ((2 * dsub + (p_ >> 1)) ^ ((q_ << 2) | hi)) + 8 * (p_ & 1);
    const int NT = S / 64;
    DMA_K(0, 0); DMA_K(1, 1); DMA_V(0, 0); DMA_K(2, 2); DMA_V(1, 1); DMA_K(3, 3); DMA_V(2, 2);
    f32x16 o[4], negm; float lsum = 0.f, lsb = 0.f, lsc = 0.f, lsd = 0.f;
#pragma unroll
    for (int d = 0; d < 4; ++d) o[d] = (f32x16){};
    {
        const int seq = rowbase < (size_t)TP ? (int)(rowbase >> 14) : 2 + (int)((rowbase - TP) >> 13);
        unsigned* kp = kmax + (seq * 16 + 2 * h + hd) * 2;
        const float kb = sqrtf(__uint_as_float(__hip_atomic_load(kp, __ATOMIC_RELAXED, __HIP_MEMORY_SCOPE_AGENT)) + __uint_as_float(__hip_atomic_load(kp + 1, __ATOMIC_RELAXED, __HIP_MEMORY_SCOPE_AGENT)));
        float q2 = 0.f;
#pragma unroll
        for (int st = 0; st < 4; ++st) { const u32x4 w = __builtin_bit_cast(u32x4, qf[st]);
            q2 += ((bflo(w.x) * bflo(w.x) + bfhi(w.x) * bfhi(w.x)) + (bflo(w.y) * bflo(w.y) + bfhi(w.y) * bfhi(w.y))) + ((bflo(w.z) * bflo(w.z) + bfhi(w.z) * bfhi(w.z)) + (bflo(w.w) * bflo(w.w) + bfhi(w.w) * bfhi(w.w))); }
        q2 += __shfl_xor(q2, 32);
        const float mref = sqrtf(q2) * kb;
#pragma unroll
        for (int r = 0; r < 16; ++r) negm[r] = -mref; }
    DMA_WAIT_BAR();
    bf16x8 kf[8], va[4], vb[4];
#define RD_K(slot) do { const LAS unsigned char* kp_ = L + (slot) * ASLOT; \
        _Pragma("unroll") for (int st = 0; st < 4; ++st) { kf[2 * st] = *(const LAS bf16x8*)(kp_ + (kb0 ^ (32 * st))); kf[2 * st + 1] = *(const LAS bf16x8*)(kp_ + 8192 + (kb0 ^ (32 * st))); } } while (0)
#define RD_V(dst, slot, s) do { const LAS unsigned char* vp_ = L + (slot) * ASLOT; \
        _Pragma("unroll") for (int d = 0; d < 4; ++d) dst[d] = cat8(ldtr(vp_ + (vb0 ^ (64 * d)) + 4096 * (s)), ldtr(vp_ + ((vb0 ^ (64 * d)) ^ 32) + 4096 * (s) + 2048)); } while (0)
#define PV5(src, pfs) do { _Pragma("unroll") for (int d = 0; d < 4; ++d) o[d] = __builtin_amdgcn_mfma_f32_32x32x16_bf16(src[d], pfs, o[d], 0, 0, 0); } while (0)
    RD_K(0);
    __syncthreads();
    bf16x8 pf[4];
#define EXPQ(SV, B, DST) do { \
        _Pragma("unroll") for (int r = 0; r < 8; ++r) SV[(B) + r] = __builtin_amdgcn_exp2f(SV[(B) + r]); \
        _Pragma("unroll") for (int r = 0; r < 8; r += 4) { asm("v_add_f32_e32 %0, %1, %0" : "+v"(lsum) : "v"(SV[(B) + r])); asm("v_add_f32_e32 %0, %1, %0" : "+v"(lsb) : "v"(SV[(B) + r + 1])); asm("v_add_f32_e32 %0, %1, %0" : "+v"(lsc) : "v"(SV[(B) + r + 2])); asm("v_add_f32_e32 %0, %1, %0" : "+v"(lsd) : "v"(SV[(B) + r + 3])); }     \
        u32x4 w_; w_.x = pk2(SV[(B)], SV[(B) + 1]); w_.y = pk2(SV[(B) + 2], SV[(B) + 3]); w_.z = pk2(SV[(B) + 4], SV[(B) + 5]); w_.w = pk2(SV[(B) + 6], SV[(B) + 7]); DST = __builtin_bit_cast(bf16x8, w_); } while (0)
#define MIX4() do { _Pragma("unroll") for (int i_ = 0; i_ < 4; ++i_) { __builtin_amdgcn_sched_group_barrier(0x008, 1, 0); __builtin_amdgcn_sched_group_barrier(0x002, 5, 0); } } while (0)
#define TILE(tt, SL) do { \
        { const int tk = ((tt) + 4 < NT) ? (tt) + 4 : NT - 1, tv = ((tt) + 3 < NT) ? (tt) + 3 : NT - 1;     \
          const bf16_t* pk_ = kbase + (size_t)(64 * tk) * 256; const bf16_t* pv_ = kbase + (size_t)(64 * tv) * 256 + 128; \
          glds16x4(pk_, pk_ + (size_t)32 * 256, pv_, pv_ + (size_t)32 * 256, kgo, dK + (SL) * ASLOT, dK + (SL) * ASLOT + 8192, dV + (((SL) + 3) & 3) * ASLOT, dV + (((SL) + 3) & 3) * ASLOT + 8192); } \
        ASB(); \
        f32x16 s0 = __builtin_amdgcn_mfma_f32_32x32x16_bf16(kf[0], qf[0], negm, 0, 0, 0); \
        f32x16 s1 = __builtin_amdgcn_mfma_f32_32x32x16_bf16(kf[1], qf[0], negm, 0, 0, 0); \
        _Pragma("unroll") for (int st = 1; st < 4; ++st) { s0 = __builtin_amdgcn_mfma_f32_32x32x16_bf16(kf[2 * st], qf[st], s0, 0, 0, 0); s1 = __builtin_amdgcn_mfma_f32_32x32x16_bf16(kf[2 * st + 1], qf[st], s1, 0, 0, 0); } \
        ASB(); \
        RD_V(va, SL, 0); RD_V(vb, SL, 1); \
        ASB(); \
        EXPQ(s0, 0, pf[0]); \
        ASB(); \
        PV5(va, pf[0]); EXPQ(s0, 8, pf[1]); MIX4(); \
        ASB(); \
        RD_V(va, SL, 2); \
        PV5(vb, pf[1]); EXPQ(s1, 0, pf[2]); MIX4(); \
        ASB(); \
        RD_V(vb, SL, 3); \
        PV5(va, pf[2]); EXPQ(s1, 8, pf[3]); MIX4(); \
        ASB(); \
        RD_K(((SL) + 1) & 3);     \
        PV5(vb, pf[3]); \
        ASB(); \
        DMA_WAIT8_BAR(); } while (0)
    for (int t = 0; t < NT; t += 4) { TILE(t, 0); TILE(t + 1, 1); TILE(t + 2, 2); TILE(t + 3, 3); }
#undef TILE
#undef EXPQ
#undef MIX4
    DMA_WAIT_BAR();
#undef DMA_K
#undef DMA_V
#undef DMA_WAIT_BAR
#undef DMA_WAIT8_BAR
#undef RD_K
#undef RD_V
#undef PV5
    lsum = (lsum + lsb) + (lsc + lsd);
    const float inv = 1.f / (lsum + __shfl_xor(lsum, 32));
    LAS float* X = (LAS float*)L;
    const int xo = (32 * qblk + r32) * AXP + 4 * hi;
    if (hd == 1) { const float sc = inv * lam;
#pragma unroll
        for (int d = 0; d < 4; ++d)
#pragma unroll
            for (int rg = 0; rg < 4; ++rg) *(LAS f32x4*)(X + xo + 32 * d + 8 * rg) = (f32x4){o[d][4 * rg] * sc, o[d][4 * rg + 1] * sc, o[d][4 * rg + 2] * sc, o[d][4 * rg + 3] * sc}; }
    __syncthreads();
    if (hd == 0) { float ss = 0.f;
#pragma unroll
        for (int d = 0; d < 4; ++d)
#pragma unroll
            for (int rg = 0; rg < 4; ++rg) { const f32x4 x = *(const LAS f32x4*)(X + xo + 32 * d + 8 * rg);
#pragma unroll
                for (int k = 0; k < 4; ++k) { const float v = o[d][4 * rg + k] * inv - x[k]; o[d][4 * rg + k] = v; ss += v * v; } }
        ss += __shfl_xor(ss, 32);
        const float rms = __builtin_amdgcn_rsqf(ss * (1.f / 128.f) + 1e-5f) * (1.f - LAMBDA_INIT);
        bf16_t* orow = QKV + qrow * 1024 + 128 * h + 4 * hi;
#pragma unroll
        for (int d = 0; d < 4; ++d)
#pragma unroll
            for (int rg = 0; rg < 4; ++rg) { const f32x4 w = *(const f32x4*)(subln + 32 * d + 8 * rg + 4 * hi);
                u32x2 ov; ov.x = pk2(o[d][4 * rg] * rms * w[0], o[d][4 * rg + 1] * rms * w[1]); ov.y = pk2(o[d][4 * rg + 2] * rms * w[2], o[d][4 * rg + 3] * rms * w[3]);
                *(u32x2*)(orow + 32 * d + 8 * rg) = ov; } }
    __syncthreads();
}

#define XB_TMO      128
#define XB_XCNT(j)  (256  + 64 * (j))
#define XB_XSUB(j)  (1280 + 64 * (j))
#define XB_XGEN(j)  (2304 + 64 * (j))
#define XB_TOP      3328
#define XB_TOPGEN   3392
#define XCD_BAR_WORDS 3456
#define XB_SPIN_CAP (1u << 18)

__device__ __forceinline__ unsigned xb_ld(unsigned* p)              { return __hip_atomic_load(p, __ATOMIC_RELAXED, __HIP_MEMORY_SCOPE_AGENT); }
__device__ __forceinline__ unsigned xb_add(unsigned* p, unsigned v) { return __hip_atomic_fetch_add(p, v, __ATOMIC_RELAXED, __HIP_MEMORY_SCOPE_AGENT); }
__device__ __forceinline__ unsigned xb_xcc_id() { return (unsigned)__builtin_amdgcn_s_getreg((3 << 11) | 20) & 0xFu; }
#define XB_SPIN(cond, bar) do { unsigned _sp = 0; while (cond) { __builtin_amdgcn_s_sleep(1); \
    if ((++_sp & 255u) == 0u) { if (xb_ld(&(bar)[XB_TMO])) break; if (_sp > XB_SPIN_CAP) { atomicAdd(&(bar)[XB_TMO], 1u); break; } } } } while (0)

struct XcdBarrier {
    unsigned* bar; unsigned x;
    volatile LAS unsigned* st;
};

__device__ __forceinline__ XcdBarrier xcd_barrier_post(unsigned* bar, volatile LAS unsigned* st) {
    XcdBarrier b; b.bar = bar; b.x = xb_xcc_id(); b.st = st;
    if (threadIdx.x == 0) (void)xb_add(&bar[XB_XCNT(b.x)], 1u);
    return b;
}
__device__ __forceinline__ void xcd_barrier_complete(unsigned* bar, unsigned x, unsigned& nloc, unsigned& nx) {
    const unsigned G = gridDim.x * gridDim.y * gridDim.z;
    unsigned sum, cnt, mine, sp = 0u;
    for (;;) {
        sum = 0u; cnt = 0u; mine = 0u;
#pragma unroll
        for (unsigned j = 0; j < 16; ++j) { const unsigned c = xb_ld(&bar[XB_XCNT(j)]); sum += c; cnt += (c > 0u) ? 1u : 0u; mine = (j == x) ? c : mine; }
        if (sum == G) break;
        __builtin_amdgcn_s_sleep(1);
        if ((++sp & 255u) == 0u) { if (xb_ld(&bar[XB_TMO])) break; if (sp > XB_SPIN_CAP) { atomicAdd(&bar[XB_TMO], 1u); break; } }
    }
    nloc = mine > 0u ? mine : 1u; nx = cnt > 0u ? cnt : 1u;
}

__device__ __forceinline__ void xcd_barrier(const XcdBarrier& b) {
    asm volatile("s_waitcnt vmcnt(0)" ::: "memory");
    __syncthreads();
    if (threadIdx.x == 0) {
        unsigned* bar = b.bar;
        __builtin_amdgcn_s_waitcnt(0);
        unsigned nloc = b.st[0], nx = b.st[1];
        if (nloc == 0u) { xcd_barrier_complete(bar, b.x, nloc, nx); b.st[0] = nloc; b.st[1] = nx; }
        const unsigned old = xb_add(&bar[XB_XSUB(b.x)], 1u);
        const unsigned gen = old / nloc;
        if (old + 1u == (gen + 1u) * nloc) {
            __builtin_amdgcn_fence(__ATOMIC_RELEASE, "agent");
            asm volatile("s_waitcnt vmcnt(0)" ::: "memory");
            const unsigned og = xb_add(&bar[XB_TOP], 1u);
            const unsigned tg = og / nx;
            if (og + 1u == (tg + 1u) * nx) xb_add(&bar[XB_TOPGEN], 1u);
            else XB_SPIN(xb_ld(&bar[XB_TOPGEN]) == tg, bar);
            __builtin_amdgcn_fence(__ATOMIC_ACQUIRE, "agent");
            xb_add(&bar[XB_XGEN(b.x)], 1u);
            asm volatile("s_waitcnt vmcnt(0)" ::: "memory");
        } else {
            XB_SPIN(xb_ld(&bar[XB_XGEN(b.x)]) == gen, bar);
            __builtin_amdgcn_fence(__ATOMIC_ACQUIRE, "agent");
            asm volatile("s_waitcnt vmcnt(0)" ::: "memory");
        }
    }
    __syncthreads();
}

__global__ void __launch_bounds__(512, 2) mk_fwd(Args args) {
    extern __shared__ __attribute__((aligned(16))) unsigned char lds[];
    LAS unsigned char* L = (LAS unsigned char*)lds;
    const int G = gridDim.x, bx = blockIdx.x;
    const int vcu = (G % 8 == 0) ? (bx % 8) * (G / 8) + bx / 8 : bx;
    unsigned char* ws = args.ws;
    const int lo = args.ph_lo, hi = args.ph_hi;
    bf16_t* XN = (bf16_t*)(ws + WS_XN); bf16_t* BIG = (bf16_t*)(ws + WS_BIG); float* PART = (float*)(ws + WS_PART);
    float* out = args.out;
#define IN(k) (lo <= (k) && (k) < hi)
    volatile LAS unsigned* bst = (volatile LAS unsigned*)(L + 147968);
    if (threadIdx.x < 2) bst[threadIdx.x] = 0u;
    __syncthreads();
    XcdBarrier xbar; xbar.bar = (unsigned*)ws; xbar.x = 0; xbar.st = nullptr;
    if (args.coop) xbar = xcd_barrier_post((unsigned*)ws, bst);
#define SEAM(k) do { if (IN(k) && IN((k) + 1)) { if (args.coop) { if ((k) == 0) cg::this_grid().sync(); else xcd_barrier(xbar); } } } while (0)
    if (IN(0)) { phase_prologue(args, L, vcu, G); __syncthreads(); }
    SEAM(0);
    if (IN(1)) {
        pg8::Gemm g{XN, (const bf16_t*)(ws + WS_WIN), T, NIN, DM, DM}; pg8::StaticOrder S; S.init(T, NIN, G, bx);
        EpiInProj E{BIG, (const float*)(ws + WS_TAB128)};
        pg8::gemm_phase<EpiInProj, pg8::StaticOrder, true, true>(L, g, S, E);
    }
    SEAM(1);
    if (IN(2)) { for (int u = vcu; u < NUNITS_RET; u += G) ret_kv_unit(L, BIG, XN, u, args.in[7], args.in[8]); }
    SEAM(2);
    if (IN(3)) phase_scan(args, vcu, G);
    SEAM(3);
    if (IN(4)) { phase_conv(args, vcu, G); for (int u = vcu; u < NUNITS_RET; u += G) ret_out_unit(L, BIG, XN, u, args.in[7], args.in[8], args.in[9]); }
    SEAM(4);
    if (IN(5)) {
        pg8::Gemm g{BIG, (const bf16_t*)(ws + WS_WOUT0), T, DM, DM, PW}; pg8::StaticOrder S; S.init(T, DM, G, bx);
        EpiRes<true> E{args.in[0], args.in[1] - (size_t)TP * DM, XN, PART};
        pg8::gemm_phase<EpiRes<true>, pg8::StaticOrder, true, true>(L, g, S, E);
    }
    SEAM(5);
    if (IN(6)) {
        pg8::Gemm g{XN, (const bf16_t*)(ws + WS_WGU0), T, NGU, DM, DM}; pg8::StaticOrder S; S.init(T, NGU, G, bx);
        EpiGU E{BIG, PART};
        pg8::gemm_phase<EpiGU, pg8::StaticOrder, true, true>(L, g, S, E);
    }
    SEAM(6);
    if (IN(7)) {
        pg8::Gemm g{BIG, (const bf16_t*)(ws + WS_WD0), T, DM, DFF, DFF}; pg8::StaticOrder S; S.init(T, DM, G, bx);
        EpiRes<false> E{nullptr, nullptr, XN, PART};
        pg8::gemm_phase<EpiRes<false>, pg8::StaticOrder, true, true>(L, g, S, E);
    }
    SEAM(7);
    if (IN(8)) {
        pg8::Gemm g{XN, (const bf16_t*)(ws + WS_WQKV), T, NQKV, DM, DM}; pg8::StaticOrder S; S.init(T, NQKV, G, bx);
        EpiQKV E{BIG, (const float*)(ws + WS_TAB64), PART, (unsigned*)ws + 3584};
        pg8::gemm_phase<EpiQKV, pg8::StaticOrder, true, true>(L, g, S, E);
    }
    SEAM(8);
    if (IN(9)) {
        float d1 = 0.f, d2 = 0.f;
        for (int i = 0; i < 64; ++i) { d1 += args.in[12][i] * args.in[13][i]; d2 += args.in[14][i] * args.in[15][i]; }
        const float lam = __expf(d1) - __expf(d2) + LAMBDA_INIT;
        unsigned* aq = (unsigned*)ws + 3904; const unsigned xcc = xb_xcc_id() & 7u;
        volatile LAS unsigned* qw = (volatile LAS unsigned*)(L + 147968 + 32);
        for (;;) {
            if (threadIdx.x == 0) { unsigned got = 0xFFFFFFFFu;
                for (unsigned tr = 0; tr < 8u; ++tr) { const unsigned q = (xcc + tr) & 7u; const unsigned idx = __hip_atomic_fetch_add(aq + 16 * q, 1u, __ATOMIC_RELAXED, __HIP_MEMORY_SCOPE_AGENT); if (idx < 768u) { got = q * 768u + idx; break; } }
                qw[0] = got; }
            __syncthreads();
            const unsigned wq = qw[0];
            __syncthreads();
            if (wq == 0xFFFFFFFFu) break;
            const int xcd = (int)(wq / 768u), rem = (int)(wq % 768u), i = rem >> 5, j = rem & 31;
            size_t rowbase; int S, h, qb;
            if (i < 8) { const int pair = 2 * xcd + (i >> 2); rowbase = (size_t)(pair >> 3) * SP; S = SP; h = pair & 7; qb = (i & 3) * 32 + j; }
            else { const int i2 = i - 8, pair = 8 * xcd + (i2 >> 1); rowbase = (size_t)TP + (size_t)(pair >> 3) * SSQ; S = SSQ; h = pair & 7; qb = (i2 & 1) * 32 + j; }
            attn_unit(L, BIG, rowbase, S, h, qb, lam, args.in[16], (unsigned*)ws + 3584);
        }
    }
    SEAM(9);
    if (IN(10)) {
        pg8::Gemm g{BIG, (const bf16_t*)(ws + WS_WO1), T, DM, DM, DM}; pg8::StaticOrder S; S.init(T, DM, G, bx);
        EpiRes<false> E{nullptr, nullptr, XN, PART};
        pg8::gemm_phase<EpiRes<false>, pg8::StaticOrder, true, true>(L, g, S, E);
    }
    SEAM(10);
    if (IN(11)) {
        pg8::Gemm g{XN, (const bf16_t*)(ws + WS_WGU1), T, NGU, DM, DM}; pg8::StaticOrder S; S.init(T, NGU, G, bx);
        EpiGU E{BIG, PART};
        pg8::gemm_phase<EpiGU, pg8::StaticOrder, true, true>(L, g, S, E);
    }
    SEAM(11);
    if (IN(12)) {
        pg8::Gemm g{BIG, (const bf16_t*)(ws + WS_WD1), T, DM, DFF, DFF}; pg8::StaticOrder S; S.init(T, DM, G, bx);
        EpiRes<false> E{nullptr, nullptr, XN, PART};
        pg8::gemm_phase<EpiRes<false>, pg8::StaticOrder, true, true>(L, g, S, E);
    }
    SEAM(12);
    if (IN(13)) {
        const int lane = threadIdx.x & 63, wave = threadIdx.x >> 6, gw = vcu * 8 + wave, NGW = G * 8;
        f32x4 w[4];
#pragma unroll
        for (int j = 0; j < 2; ++j) { w[2 * j] = ((const f32x4*)args.in[4])[2 * (lane + 64 * j)]; w[2 * j + 1] = ((const f32x4*)args.in[4])[2 * (lane + 64 * j) + 1]; }
        for (int m = gw; m < T; m += NGW) {
            const float rs = row_scale(PART, m);
            const u32x4* xr = (const u32x4*)(XN + (size_t)m * DM); f32x4* yr = (f32x4*)(out + (size_t)m * DM);
#pragma unroll
            for (int j = 0; j < 2; ++j) { const u32x4 v = xr[lane + 64 * j];
                yr[2 * (lane + 64 * j)] = (f32x4){bflo(v.x), bfhi(v.x), bflo(v.y), bfhi(v.y)} * rs * w[2 * j];
                yr[2 * (lane + 64 * j) + 1] = (f32x4){bflo(v.z), bfhi(v.z), bflo(v.w), bfhi(v.w)} * rs * w[2 * j + 1]; }
        }
    }
#undef IN
#undef SEAM
}

extern "C" void kernel_launch(void* const* d_in, const int* in_sizes, int n_in, void* d_out, int out_size, void* d_ws, size_t ws_size, hipStream_t stream) {
    static int grid = 0;
    if (grid == 0) {
        if (n_in != 21 || out_size != T * DM || ws_size < WS_END) { fprintf(stderr, "kernel_launch: unexpected shapes: n_in %d out %d ws %zu (need %zu)\n", n_in, out_size, ws_size, (size_t)WS_END); grid = -1; return; }
        int dev = 0, cus = 0, per_cu = 0;
        hipGetDevice(&dev); hipDeviceGetAttribute(&cus, hipDeviceAttributeMultiprocessorCount, dev);
        if (hipFuncSetAttribute((const void*)mk_fwd, hipFuncAttributeMaxDynamicSharedMemorySize, LDS_BYTES) != hipSuccess) { fprintf(stderr, "kernel_launch: hipFuncSetAttribute failed\n"); grid = -1; return; }
        if (hipOccupancyMaxActiveBlocksPerMultiprocessor(&per_cu, (const void*)mk_fwd, 512, LDS_BYTES) != hipSuccess || per_cu < 1) { fprintf(stderr, "kernel_launch: occupancy query says %d\n", per_cu); per_cu = 1; }
        (void)hipGetLastError();
        grid = cus * 1;
    }
    if (grid < 0) return;
    if (hipMemsetAsync(d_ws, 0, 16384, stream) != hipSuccess) { fprintf(stderr, "kernel_launch: hipMemsetAsync failed\n"); return; }
    Args a{};
    for (int i = 0; i < 21; ++i) a.in[i] = (const float*)d_in[i];
    a.out = (float*)d_out; a.ws = (unsigned char*)d_ws;
#if MK_MULTI
    for (int p = 0; p < 14; ++p) { a.ph_lo = p; a.ph_hi = p + 1; a.coop = 0; hipLaunchKernelGGL(mk_fwd, dim3(grid), dim3(512), LDS_BYTES, stream, a); }
#else
    a.ph_lo = 0; a.ph_hi = 14; a.coop = 1;
    void* kargs[] = {&a};
    hipError_t e = hipLaunchCooperativeKernel((const void*)mk_fwd, dim3(grid), dim3(512), kargs, LDS_BYTES, stream);
    if (e != hipSuccess) fprintf(stderr, "cooperative launch failed: %s (grid %d)\n", hipGetErrorString(e), grid);
#endif
}
```
